# Optimizing an MI355X kernel written in HIP

```python
import math
import jax
import jax.numpy as jnp
from jax import lax
import numpy as np

D_MODEL = 2048
BATCH = 4
SEQ = 8192
DEPTH = 1

CHUNK = 64
EPS = 1e-6
M_WIDTH = D_MODEL // 2
M_HEADS = 4
M_HEAD_DIM = M_WIDTH // M_HEADS
CONV_WIDTH = 4
S_WIDTH = D_MODEL // 4
S_GROUP = 16
S_GROUPS = S_WIDTH // S_GROUP
S_STATE = 64
STEP_MIN = 1e-3
STEP_MAX = 1e-1
N_BRANCH = 2
IN_COLS = 2 * M_WIDTH + S_WIDTH + N_BRANCH * D_MODEL
FFN_HIDDEN = ((-(-8 * D_MODEL // 3) + 255) // 256) * 256

kernel_name = 'hybrid_mlstm_s5_gated_block'


def rms_norm(x, g):
    xf = x.astype(jnp.float32)
    y = xf * lax.rsqrt(jnp.mean(xf * xf, axis=-1, keepdims=True) + EPS)
    return (y * g.astype(jnp.float32)).astype(x.dtype)


def causal_depthwise_conv(x, w, b):
    k_w = w.shape[0]
    s = x.shape[1]
    xp = jnp.pad(x, ((0, 0), (k_w - 1, 0), (0, 0)))
    y = b
    for j in range(k_w):
        y = y + xp[:, j:j + s, :] * w[j]
    return y


def mlstm_chunkwise(q, k, v, log_i, log_f):
    bsz, nh, s, dh = q.shape
    nc = s // CHUNK

    def to_chunks(t):
        t = t.reshape((bsz, nh, nc, CHUNK) + t.shape[3:])
        return jnp.moveaxis(t, 2, 0)

    mask = jnp.tril(jnp.ones((CHUNK, CHUNK), dtype=bool))

    def step(carry, inp):
        c_st, n_st, m_st = carry
        q_, k_, v_, li, lf = inp
        b = jnp.cumsum(lf, axis=-1)
        dmat = jnp.where(mask, b[..., :, None] - b[..., None, :] + li[..., None, :], -jnp.inf)
        m_inter = b + m_st[..., None]
        m_t = jnp.maximum(m_inter, jnp.max(dmat, axis=-1))
        w_intra = jnp.exp(dmat - m_t[..., None])
        w_inter = jnp.exp(m_inter - m_t)
        sc = jnp.einsum('bhtd,bhsd->bhts', q_, k_) * w_intra
        num = jnp.einsum('bhts,bhse->bhte', sc, v_) + w_inter[..., None] * jnp.einsum('bhed,bhtd->bhte', c_st, q_)
        den = jnp.sum(sc, axis=-1) + w_inter * jnp.einsum('bhd,bhtd->bht', n_st, q_)
        h = num / jnp.maximum(jnp.abs(den), jnp.exp(-m_t))[..., None]
        b_last = b[..., -1]
        w_s = b_last[..., None] - b + li
        m_new = jnp.maximum(b_last + m_st, jnp.max(w_s, axis=-1))
        decay = jnp.exp(b_last + m_st - m_new)
        ws = jnp.exp(w_s - m_new[..., None])
        c_new = decay[..., None, None] * c_st + jnp.einsum('bhs,bhse,bhsd->bhed', ws, v_, k_)
        n_new = decay[..., None] * n_st + jnp.einsum('bhs,bhsd->bhd', ws, k_)
        return (c_new, n_new, m_new), h

    init = (jnp.zeros((bsz, nh, dh, dh), jnp.float32),
            jnp.zeros((bsz, nh, dh), jnp.float32),
            jnp.zeros((bsz, nh), jnp.float32))
    _, hc = lax.scan(step, init, (to_chunks(q), to_chunks(k), to_chunks(v), to_chunks(log_i), to_chunks(log_f)))
    return jnp.moveaxis(hc, 0, 2).reshape(bsz, nh, s, dh)


def mlstm_branch(x_m, o_pre, conv_w, conv_b, w_q, w_k, w_v, w_if, b_if, mh_g, skip):
    f32 = jnp.float32
    bsz, s, _ = x_m.shape
    xc = jax.nn.silu(causal_depthwise_conv(x_m, conv_w, conv_b))
    xc_h = xc.reshape(bsz, s, M_HEADS, M_HEAD_DIM)
    xm_h = x_m.reshape(bsz, s, M_HEADS, M_HEAD_DIM)
    q = jnp.einsum('bshd,hde->bshe', xc_h, w_q)
    k = jnp.einsum('bshd,hde->bshe', xc_h, w_k) * (M_HEAD_DIM ** -0.5)
    v = jnp.einsum('bshd,hde->bshe', xm_h, w_v)
    qkv = jnp.concatenate([q, k, v], axis=2).reshape(bsz, s, 3 * M_WIDTH)
    gates = (qkv @ w_if + b_if).astype(f32)
    log_i = gates[..., :M_HEADS]
    log_f = jax.nn.log_sigmoid(gates[..., M_HEADS:])
    to_bh = lambda t: jnp.swapaxes(t.astype(f32), 1, 2)
    hcell = mlstm_chunkwise(to_bh(q), to_bh(k), to_bh(v), to_bh(log_i), to_bh(log_f))
    hcell = jnp.swapaxes(hcell, 1, 2)
    hn = hcell * lax.rsqrt(jnp.mean(hcell * hcell, axis=-1, keepdims=True) + EPS)
    hn = hn * mh_g.astype(f32).reshape(M_HEADS, M_HEAD_DIM)
    out = jax.nn.sigmoid(o_pre.astype(f32)) * (hn.reshape(bsz, s, M_WIDTH) + skip.astype(f32) * xc.astype(f32))
    return out.astype(x_m.dtype)


def linear_recurrence_combine(e_i, e_j):
    a_i, b_i = e_i
    a_j, b_j = e_j
    return a_j * a_i, a_j * b_i + b_j


def s5_branch(u, a_re, a_im, log_step, b_re, b_im, c_re, c_im, d, w_glu, b_glu):
    f32 = jnp.float32
    bsz, s, _ = u.shape
    lam = lax.complex(a_re.astype(f32), a_im.astype(f32))
    step = jnp.exp(log_step.astype(f32))[:, None]
    a_bar = jnp.exp(lam * step)
    b_mat = lax.complex(b_re.astype(f32), b_im.astype(f32))
    b_bar = ((a_bar - 1.0) / lam)[..., None] * b_mat
    c_mat = lax.complex(c_re.astype(f32), c_im.astype(f32))
    uf = u.astype(f32)
    ug = uf.reshape(bsz, s, S_GROUPS, S_GROUP).astype(jnp.complex64)
    bu = jnp.einsum('gpc,bsgc->bsgp', b_bar, ug)
    a_seq = jnp.broadcast_to(a_bar[None, None], (1, s, S_GROUPS, S_STATE))
    _, states = lax.associative_scan(linear_recurrence_combine, (a_seq, bu), axis=1)
    y = jnp.einsum('gcp,bsgp->bsgc', c_mat, states).real.reshape(bsz, s, S_WIDTH)
    y = y + d.astype(f32) * uf
    y = jax.nn.gelu(y)
    y = y * jax.nn.sigmoid(y @ w_glu.astype(f32) + b_glu.astype(f32))
    return y.astype(u.dtype)


def setup_inputs(seed: int = 0) -> dict:
    key = jax.random.key(seed)
    ks = iter(jax.random.split(key, 40))
    f32 = jnp.float32
    L = DEPTH

    def nrm(shape, scale):
        return jax.random.normal(next(ks), shape, f32) * scale

    x = nrm((BATCH, SEQ, D_MODEL), 1.0)
    norm_mix_g = 1.0 + nrm((L, D_MODEL), 0.02)
    w_in = nrm((L, D_MODEL, IN_COLS), D_MODEL ** -0.5)
    conv_w = nrm((L, CONV_WIDTH, M_WIDTH), CONV_WIDTH ** -0.5)
    conv_b = nrm((L, M_WIDTH), 0.02)
    w_q = nrm((L, M_HEADS, M_HEAD_DIM, M_HEAD_DIM), M_HEAD_DIM ** -0.5)
    w_k = nrm((L, M_HEADS, M_HEAD_DIM, M_HEAD_DIM), M_HEAD_DIM ** -0.5)
    w_v = nrm((L, M_HEADS, M_HEAD_DIM, M_HEAD_DIM), M_HEAD_DIM ** -0.5)
    w_if = nrm((L, 3 * M_WIDTH, 2 * M_HEADS), (3 * M_WIDTH) ** -0.5)
    b_if = jnp.concatenate([nrm((L, M_HEADS), 0.1),
                            jnp.linspace(3.0, 6.0, M_HEADS, dtype=f32)[None] + nrm((L, M_HEADS), 0.1)], axis=-1)
    mh_norm_g = 1.0 + nrm((L, M_WIDTH), 0.02)
    skip = 1.0 + nrm((L, M_WIDTH), 0.02)
    w_up_m = nrm((L, M_WIDTH, D_MODEL), M_WIDTH ** -0.5)
    s5_a_re = -0.5 + nrm((L, S_GROUPS, S_STATE), 0.01)
    s5_a_im = math.pi * jnp.arange(S_STATE, dtype=f32) * (1.0 + nrm((L, S_GROUPS, S_STATE), 0.01))
    s5_log_step = jax.random.uniform(next(ks), (L, S_GROUPS), f32, math.log(STEP_MIN), math.log(STEP_MAX))
    s5_b_re = nrm((L, S_GROUPS, S_STATE, S_GROUP), (2 * S_GROUP) ** -0.5)
    s5_b_im = nrm((L, S_GROUPS, S_STATE, S_GROUP), (2 * S_GROUP) ** -0.5)
    s5_c_re = nrm((L, S_GROUPS, S_GROUP, S_STATE), S_STATE ** -0.5)
    s5_c_im = nrm((L, S_GROUPS, S_GROUP, S_STATE), S_STATE ** -0.5)
    s5_d = nrm((L, S_WIDTH), 1.0)
    w_glu = nrm((L, S_WIDTH, S_WIDTH), S_WIDTH ** -0.5)
    b_glu = nrm((L, S_WIDTH), 0.02)
    w_up_s = nrm((L, S_WIDTH, D_MODEL), S_WIDTH ** -0.5)
    b_gate = nrm((L, N_BRANCH * D_MODEL), 0.02)
    w_out = nrm((L, D_MODEL, D_MODEL), D_MODEL ** -0.5)
    norm_ffn_g = 1.0 + nrm((L, D_MODEL), 0.02)
    w_ffn_gate = nrm((L, D_MODEL, FFN_HIDDEN), D_MODEL ** -0.5)
    w_ffn_up = nrm((L, D_MODEL, FFN_HIDDEN), D_MODEL ** -0.5)
    w_ffn_down = nrm((L, FFN_HIDDEN, D_MODEL), FFN_HIDDEN ** -0.5)
    norm_final_g = 1.0 + nrm((D_MODEL,), 0.02)
    return {'x': x, 'norm_mix_g': norm_mix_g, 'w_in': w_in, 'conv_w': conv_w, 'conv_b': conv_b,
            'w_q': w_q, 'w_k': w_k, 'w_v': w_v, 'w_if': w_if, 'b_if': b_if,
            'mh_norm_g': mh_norm_g, 'skip': skip, 'w_up_m': w_up_m,
            's5_a_re': s5_a_re, 's5_a_im': s5_a_im, 's5_log_step': s5_log_step,
            's5_b_re': s5_b_re, 's5_b_im': s5_b_im, 's5_c_re': s5_c_re, 's5_c_im': s5_c_im,
            's5_d': s5_d, 'w_glu': w_glu, 'b_glu': b_glu, 'w_up_s': w_up_s,
            'b_gate': b_gate, 'w_out': w_out, 'norm_ffn_g': norm_ffn_g,
            'w_ffn_gate': w_ffn_gate, 'w_ffn_up': w_ffn_up, 'w_ffn_down': w_ffn_down,
            'norm_final_g': norm_final_g}


def reference(x, norm_mix_g, w_in, conv_w, conv_b, w_q, w_k, w_v, w_if, b_if,
              mh_norm_g, skip, w_up_m, s5_a_re, s5_a_im, s5_log_step,
              s5_b_re, s5_b_im, s5_c_re, s5_c_im, s5_d, w_glu, b_glu, w_up_s,
              b_gate, w_out, norm_ffn_g, w_ffn_gate, w_ffn_up, w_ffn_down, norm_final_g):
    bsz, s, _ = x.shape
    c0 = M_WIDTH
    c1 = 2 * M_WIDTH
    c2 = 2 * M_WIDTH + S_WIDTH
    for l in range(DEPTH):
        h = rms_norm(x, norm_mix_g[l])
        p = h @ w_in[l]
        y_m = mlstm_branch(p[..., :c0], p[..., c0:c1], conv_w[l], conv_b[l], w_q[l], w_k[l], w_v[l],
                           w_if[l], b_if[l], mh_norm_g[l], skip[l]) @ w_up_m[l]
        y_s = s5_branch(p[..., c1:c2], s5_a_re[l], s5_a_im[l], s5_log_step[l], s5_b_re[l], s5_b_im[l],
                        s5_c_re[l], s5_c_im[l], s5_d[l], w_glu[l], b_glu[l]) @ w_up_s[l]
        g = jax.nn.sigmoid(p[..., c2:].reshape(bsz, s, N_BRANCH, D_MODEL) + b_gate[l].reshape(N_BRANCH, D_MODEL))
        merged = g[..., 0, :] * y_m + g[..., 1, :] * y_s
        x = x + merged @ w_out[l]
        h2 = rms_norm(x, norm_ffn_g[l])
        x = x + (jax.nn.silu(h2 @ w_ffn_gate[l]) * (h2 @ w_ffn_up[l])) @ w_ffn_down[l]
    return rms_norm(x, norm_final_g)
```

```cpp
#include <hip/hip_runtime.h>
#include <cstdio>
#include <cstdint>

#define LAS __attribute__((address_space(3)))
#define GAS __attribute__((address_space(1)))
typedef unsigned short bf16_t;
typedef short bf16x8 __attribute__((ext_vector_type(8)));
typedef float f32x4 __attribute__((ext_vector_type(4)));
typedef unsigned u32x4 __attribute__((ext_vector_type(4)));
typedef GAS unsigned gu32;

constexpr int BATCH = 4, SEQ = 8192, DM = 2048, M = BATCH * SEQ;
constexpr int MW = 1024, NH = 4, DH = 256, SW = 512, NG = 32, SP = 64;
constexpr int INC = 6656, FF = 5632;
constexpr int LC = 256, NCH = SEQ / LC;
constexpr int NJ = M / 16;
constexpr float EPS = 1e-6f;
constexpr int NWAVES = 8, NTHR = 512;

constexpr size_t MiB = 1u << 20, KiB = 1u << 10;
constexpr size_t WS_CTL = 0, CTL_ZERO_BYTES = 64 * KiB;
constexpr size_t WS_RSTD1 = 1 * MiB, WS_SSQ2 = 1 * MiB + 128 * KiB, WS_SSQ3 = 1 * MiB + 256 * KiB;
constexpr size_t WS_TA = 1 * MiB + 512 * KiB, WS_TB = 2 * MiB, WS_TPM = 2 * MiB + 512 * KiB, WS_RDN = 3 * MiB, WS_CS = 3 * MiB + 512 * KiB;
constexpr size_t WS_GRAW = 4 * MiB, WS_DENP = 6 * MiB, WS_NLP = 8 * MiB;
constexpr size_t WS_WIN = 10 * MiB, WS_WGU = 36 * MiB, WS_WD = 80 * MiB, WS_WOUT = 102 * MiB, WS_WUPM = 110 * MiB, WS_WUPS = 114 * MiB, WS_WGLU = 116 * MiB;
constexpr size_t WS_WQ = 116 * MiB + 512 * KiB, WS_WK = 117 * MiB, WS_WV = 117 * MiB + 512 * KiB, WS_WG = 118 * MiB, WS_EMAT = 119 * MiB, WS_T16O = 123 * MiB;
constexpr size_t WS_XB = 130 * MiB, WS_VC = 130 * MiB, WS_MERGED = 130 * MiB;
constexpr size_t WS_SIGO = 258 * MiB, WS_UP = 322 * MiB, WS_XCM = 370 * MiB, WS_E = 498 * MiB, WS_Q = 530 * MiB, WS_K = 594 * MiB, WS_KT = 658 * MiB, WS_VWT = 722 * MiB;
constexpr size_t WS_SQ = 786 * MiB, WS_DCL = 914 * MiB, WS_YSP = 978 * MiB, WS_YS = 594 * MiB, WS_TMP = 658 * MiB, WS_OUTM = 914 * MiB, WS_X1B = 258 * MiB, WS_HB = 386 * MiB;
constexpr size_t WS_END = 1010 * MiB;

__device__ __forceinline__ unsigned cvt_pk_bf16(float lo, float hi) { unsigned r; asm volatile("v_cvt_pk_bf16_f32 %0, %1, %2" : "=v"(r) : "v"(lo), "v"(hi)); return r; }
__device__ __forceinline__ float bf2f(unsigned short b) { return __uint_as_float((unsigned)b << 16); }
__device__ __forceinline__ unsigned short f2bf(float f) { return (unsigned short)(cvt_pk_bf16(f, 0.f) & 0xffffu); }
__device__ __forceinline__ float bfround(float f) { return __uint_as_float(cvt_pk_bf16(f, 0.f) << 16); }
__device__ __forceinline__ void st8bf(bf16_t* p, const float (&v)[8]) {
    u32x4 w; w.x = cvt_pk_bf16(v[0], v[1]); w.y = cvt_pk_bf16(v[2], v[3]); w.z = cvt_pk_bf16(v[4], v[5]); w.w = cvt_pk_bf16(v[6], v[7]); *(u32x4*)p = w; }
__device__ __forceinline__ void ld8bf(const bf16_t* p, float (&v)[8]) {
    const u32x4 w = *(const u32x4*)p;
    v[0] = __uint_as_float(w.x << 16); v[1] = __uint_as_float(w.x & 0xffff0000u); v[2] = __uint_as_float(w.y << 16); v[3] = __uint_as_float(w.y & 0xffff0000u);
    v[4] = __uint_as_float(w.z << 16); v[5] = __uint_as_float(w.z & 0xffff0000u); v[6] = __uint_as_float(w.w << 16); v[7] = __uint_as_float(w.w & 0xffff0000u); }
__device__ __forceinline__ void st8f(float* p, const float (&v)[8]) { *(f32x4*)p = (f32x4){v[0], v[1], v[2], v[3]}; *(f32x4*)(p + 4) = (f32x4){v[4], v[5], v[6], v[7]}; }
__device__ __forceinline__ void ld8f(const float* p, float (&v)[8]) { const f32x4 a = *(const f32x4*)p, b = *(const f32x4*)(p + 4); v[0] = a[0]; v[1] = a[1]; v[2] = a[2]; v[3] = a[3]; v[4] = b[0]; v[5] = b[1]; v[6] = b[2]; v[7] = b[3]; }
__device__ __forceinline__ float sigmoidf_(float x) { return __builtin_amdgcn_rcpf(1.f + __expf(-x)); }
__device__ __forceinline__ float ldu(const float* p) { return __uint_as_float(__hip_atomic_load((const unsigned*)p, __ATOMIC_RELAXED, __HIP_MEMORY_SCOPE_AGENT)); }
__device__ __forceinline__ float wave_sum(float v) {
#pragma unroll
    for (int o = 1; o < 64; o <<= 1) v += __shfl_xor(v, o);
    return v; }

namespace pg8 {
constexpr int BM = 256, BK = 64, HALF = 128, HTB = HALF * BK * 2, STAGE_BYTES = 8 * HTB;
__host__ __device__ __forceinline__ int lds_byte(int r, int c) { const int st = (r >> 4) * 2 + (c >> 5), rr = r & 15, cc = c & 31, ob = rr * 64 + cc * 2; return st * 1024 + (ob ^ (((ob >> 9) & 1) << 5)); }
__host__ __device__ __forceinline__ void stage_rc(int b, int& R, int& C) { const int st = b / 1024, sb = b % 1024, swz = sb ^ (((sb >> 9) & 1) << 5); R = (st >> 1) * 16 + swz / 64; C = (st & 1) * 32 + (swz % 64) / 2; }
__host__ __device__ __forceinline__ int perm32(int rho) { const int n = rho >> 4, i = rho & 15; return 8 * (i >> 2) + 4 * n + (i & 3); }
}
struct Unit { int pm, pn, z; const char* a; const char* b; };

template <int MODE, class F>
__device__ __forceinline__ void run_epilogue(f32x4 (&acc)[2][2][4][2], const Unit& u, F& f, int wr, int wc, int fr, int fq, LAS float* xch) {
    asm volatile("" : "+v"(fr), "+v"(fq));
    asm volatile("" : "+s"(wr), "+s"(wc));
    f.begin(u);
    if constexpr (MODE == 0 || MODE == 1) {
#pragma unroll
        for (int ai = 0; ai < 2; ++ai)
#pragma unroll
            for (int m = 0; m < 4; ++m) { const int rl = ai * 128 + wr * 64 + m * 16 + fr; float part = 0.f;
#pragma unroll
                for (int bj = 0; bj < 2; ++bj) { float v[8]; const f32x4 a0 = acc[ai][bj][m][0], a1 = acc[ai][bj][m][1];
                    v[0] = a0[0]; v[1] = a0[1]; v[2] = a0[2]; v[3] = a0[3]; v[4] = a1[0]; v[5] = a1[1]; v[6] = a1[2]; v[7] = a1[3];
                    const int cl = bj * 128 + wc * 32 + fq * 8;
                    if constexpr (MODE == 0) f.store(u, rl, cl, v); else part += f.store(u, rl, cl, v); }
                if constexpr (MODE == 1) { part += __shfl_xor(part, 16); part += __shfl_xor(part, 32); if (fq == 0) f.rowpart(u, rl, wc, part); } }
    } else if constexpr (MODE == 2) {
#pragma unroll
        for (int ai = 0; ai < 2; ++ai)
#pragma unroll
            for (int m = 0; m < 4; ++m) { const int rl = ai * 128 + wr * 64 + m * 16 + fr; float part = 0.f;
#pragma unroll
                for (int bj = 0; bj < 2; ++bj) { float v[8]; const f32x4 a0 = acc[ai][bj][m][0], a1 = acc[ai][bj][m][1];
                    v[0] = a0[0]; v[1] = a0[1]; v[2] = a0[2]; v[3] = a0[3]; v[4] = a1[0]; v[5] = a1[1]; v[6] = a1[2]; v[7] = a1[3];
                    part += f.part(u, rl, bj * 128 + wc * 32 + fq * 8, v);
                    acc[ai][bj][m][0] = (f32x4){v[0], v[1], v[2], v[3]}; acc[ai][bj][m][1] = (f32x4){v[4], v[5], v[6], v[7]}; }
                part += __shfl_xor(part, 16); part += __shfl_xor(part, 32); if (fq == 0) xch[rl * 4 + wc] = part; }
        asm volatile("s_waitcnt lgkmcnt(0)" ::: "memory"); __builtin_amdgcn_s_barrier(); asm volatile("" ::: "memory");
#pragma unroll
        for (int ai = 0; ai < 2; ++ai)
#pragma unroll
            for (int m = 0; m < 4; ++m) { const int rl = ai * 128 + wr * 64 + m * 16 + fr;
                const f32x4 t4 = *(const LAS f32x4*)(xch + rl * 4); const float tot = (t4[0] + t4[1]) + (t4[2] + t4[3]);
#pragma unroll
                for (int bj = 0; bj < 2; ++bj) { float v[8]; const f32x4 a0 = acc[ai][bj][m][0], a1 = acc[ai][bj][m][1];
                    v[0] = a0[0]; v[1] = a0[1]; v[2] = a0[2]; v[3] = a0[3]; v[4] = a1[0]; v[5] = a1[1]; v[6] = a1[2]; v[7] = a1[3];
                    f.store2(u, rl, bj * 128 + wc * 32 + fq * 8, v, tot); } }
    } else {
#pragma unroll
        for (int ai = 0; ai < 2; ++ai)
#pragma unroll
            for (int m = 0; m < 4; ++m) { const int rl = ai * 128 + wr * 64 + m * 16 + fr; float vg[8], vu[8];
                const f32x4 a0 = acc[ai][0][m][0], a1 = acc[ai][0][m][1], b0 = acc[ai][1][m][0], b1 = acc[ai][1][m][1];
                vg[0] = a0[0]; vg[1] = a0[1]; vg[2] = a0[2]; vg[3] = a0[3]; vg[4] = a1[0]; vg[5] = a1[1]; vg[6] = a1[2]; vg[7] = a1[3];
                vu[0] = b0[0]; vu[1] = b0[1]; vu[2] = b0[2]; vu[3] = b0[3]; vu[4] = b1[0]; vu[5] = b1[1]; vu[6] = b1[2]; vu[7] = b1[3];
                f.store_pair(u, rl, wc * 32 + fq * 8, vg, vu); }
    }
}

template <int MODE, class F, class S>
__device__ __forceinline__ void gemm_phase(LAS unsigned char* lds, const int lda, const int ldb, const int K, const S& sched, F& fun) {
    using namespace pg8;
    int tid_ = threadIdx.x; asm volatile("" : "+v"(tid_));
    const int tid = tid_, wid = __builtin_amdgcn_readfirstlane(tid >> 6), lane = tid & 63, wr = wid >> 2, wc = wid & 3, fr = lane & 15, fq = lane >> 4;
    const int nt = K / BK;
    LAS float* xch = (LAS float*)(lds + STAGE_BYTES);
    unsigned voffA[2], voffB[2];
#pragma unroll
    for (int i = 0; i < 2; ++i) { int R, C; stage_rc(tid * 16 + i * 8192, R, C); const int Rb = (R & ~31) + perm32(R & 31);
        voffA[i] = (unsigned)(R * lda + C * 2); voffB[i] = (unsigned)(Rb * ldb + C * 2); }
    const size_t kstep = (size_t)(BK * 2);
    const size_t hstepA = (size_t)HALF * lda, hstepB = (size_t)HALF * ldb;
    const unsigned ldsw = (unsigned)wid * 1024u;
    const int aoff = lds_byte(wr * 64 + fr, fq * 8), boff = lds_byte(wc * 32 + fr, fq * 8);
#define PG8_SA(b, h) (((b) * 2 + (h)) * HTB)
#define PG8_SB(b, h) ((4 + (b) * 2 + (h)) * HTB)
#define PG8_STAGE(bufoff, gbase, voff) do { _Pragma("unroll") for (int _i = 0; _i < 2; ++_i) \
        __builtin_amdgcn_global_load_lds((const unsigned*)((const char*)(gbase) + (voff)[_i]), (LAS unsigned*)(lds + (bufoff) + ldsw + _i * 8192), 16, 0, 0); } while (0)
#define PG8_LDA(dst, b, h) do { _Pragma("unroll") for (int m = 0; m < 4; ++m) _Pragma("unroll") for (int k = 0; k < 2; ++k) dst[m][k] = *(const LAS bf16x8*)(lds + PG8_SA(b, h) + aoff + m * 2048 + k * 1024); } while (0)
#define PG8_LDB(dst, b, h) do { _Pragma("unroll") for (int n = 0; n < 2; ++n) _Pragma("unroll") for (int k = 0; k < 2; ++k) dst[n][k] = *(const LAS bf16x8*)(lds + PG8_SB(b, h) + boff + n * 2048 + k * 1024); } while (0)
#define PG8_MMA(ai, bj, At, Bt) do { __builtin_amdgcn_s_setprio(1); _Pragma("unroll") for (int m = 0; m < 4; ++m) _Pragma("unroll") for (int n = 0; n < 2; ++n) _Pragma("unroll") for (int k = 0; k < 2; ++k) \
        acc[ai][bj][m][n] = __builtin_amdgcn_mfma_f32_16x16x32_bf16(Bt[n][k], At[m][k], acc[ai][bj][m][n], 0, 0, 0); __builtin_amdgcn_s_setprio(0); } while (0)
#define PG8_WAIT_V(n) asm volatile("s_waitcnt vmcnt(" #n ")" ::: "memory")
#define PG8_WAIT_L(n) asm volatile("s_waitcnt lgkmcnt(" #n ")" ::: "memory")
#define PG8_BAR __builtin_amdgcn_s_barrier()
#define PG8_SCHED __builtin_amdgcn_sched_barrier(0)
    Unit cur, nxt; int ui = 0;
    if (!sched.next(0, cur)) return;
    f32x4 acc[2][2][4][2];
#pragma unroll
    for (int a = 0; a < 2; ++a)
#pragma unroll
        for (int b = 0; b < 2; ++b)
#pragma unroll
            for (int m = 0; m < 4; ++m)
#pragma unroll
                for (int n = 0; n < 2; ++n) acc[a][b][m][n] = (f32x4){0.f, 0.f, 0.f, 0.f};
    bf16x8 At[4][2], B0[2][2], B1[2][2];
    const char* cA = cur.a; const char* cB = cur.b;
    PG8_STAGE(PG8_SB(0, 0), cB, voffB); PG8_STAGE(PG8_SB(0, 1), cB + hstepB, voffB); PG8_STAGE(PG8_SA(0, 0), cA, voffA); PG8_STAGE(PG8_SA(0, 1), cA + hstepA, voffA);
    if (wr == 1) PG8_BAR;
    PG8_WAIT_V(2); PG8_BAR;
    PG8_STAGE(PG8_SB(1, 0), cB + kstep, voffB); PG8_STAGE(PG8_SA(1, 0), cA + kstep, voffA); PG8_STAGE(PG8_SB(1, 1), cB + hstepB + kstep, voffB);
    PG8_WAIT_V(6); PG8_BAR;
    for (;;) {
        const bool has_next = sched.next(ui + 1, nxt);
        const char* nA = has_next ? nxt.a : cA; const char* nB = has_next ? nxt.b : cB;
        for (int t = 0; t < nt; t += 2) {
            const bool last = (t == nt - 2);
            const char* a1 = cA + (size_t)(t + 1) * kstep;
            const char* a2 = last ? nA : cA + (size_t)(t + 2) * kstep; const char* b2 = last ? nB : cB + (size_t)(t + 2) * kstep;
            const char* a3 = a2 + kstep; const char* b3 = b2 + kstep;
            PG8_LDB(B0, 0, 0); PG8_LDB(B1, 0, 1); PG8_SCHED; PG8_LDA(At, 0, 0); PG8_STAGE(PG8_SA(1, 1), a1 + hstepA, voffA);
            PG8_WAIT_V(8); PG8_WAIT_L(0); PG8_BAR; PG8_MMA(0, 0, At, B0); PG8_MMA(0, 1, At, B1); PG8_BAR; PG8_SCHED;
            PG8_LDA(At, 0, 1); PG8_STAGE(PG8_SB(0, 0), b2, voffB); PG8_STAGE(PG8_SB(0, 1), b2 + hstepB, voffB); PG8_STAGE(PG8_SA(0, 0), a2, voffA);
            PG8_WAIT_V(8); PG8_WAIT_L(0); PG8_BAR; PG8_MMA(1, 0, At, B0); PG8_MMA(1, 1, At, B1); PG8_BAR; PG8_SCHED;
            PG8_LDB(B0, 1, 0); PG8_LDB(B1, 1, 1); PG8_SCHED; PG8_LDA(At, 1, 0); PG8_STAGE(PG8_SA(0, 1), a2 + hstepA, voffA);
            PG8_WAIT_V(8); PG8_WAIT_L(0); PG8_BAR; PG8_MMA(0, 0, At, B0); PG8_MMA(0, 1, At, B1); PG8_BAR; PG8_SCHED;
            PG8_LDA(At, 1, 1); PG8_STAGE(PG8_SB(1, 0), b3, voffB); PG8_STAGE(PG8_SB(1, 1), b3 + hstepB, voffB); PG8_STAGE(PG8_SA(1, 0), a3, voffA);
            PG8_WAIT_V(8); PG8_WAIT_L(0); PG8_BAR; PG8_MMA(1, 0, At, B0); PG8_MMA(1, 1, At, B1); PG8_BAR; PG8_SCHED;
        }
        if (wr == 0) PG8_BAR;
        run_epilogue<MODE, F>(acc, cur, fun, wr, wc, fr, fq, xch);
        if (!has_next) break;
#pragma unroll
        for (int a = 0; a < 2; ++a)
#pragma unroll
            for (int b = 0; b < 2; ++b)
#pragma unroll
                for (int m = 0; m < 4; ++m)
#pragma unroll
                    for (int n = 0; n < 2; ++n) acc[a][b][m][n] = (f32x4){0.f, 0.f, 0.f, 0.f};
        cur = nxt; cA = nA; cB = nB; ++ui;
        if (wr == 1) PG8_BAR;
    }
    PG8_WAIT_V(0);
    PG8_BAR;
#undef PG8_SA
#undef PG8_SB
#undef PG8_STAGE
#undef PG8_LDA
#undef PG8_LDB
#undef PG8_MMA
#undef PG8_WAIT_V
#undef PG8_WAIT_L
#undef PG8_BAR
#undef PG8_SCHED
}

template <int MODE, class F, class S>
__device__ __forceinline__ void gemm_naive(LAS unsigned char* lds, const int lda, const int ldb, const int K, const S& sched, F& fun) {
    LAS float* xch = (LAS float*)(lds + pg8::STAGE_BYTES);
    const int tid = threadIdx.x;
    Unit u;
    for (int ui = 0; sched.next(ui, u); ++ui) {
        fun.begin(u);
        for (int pass = 0; pass < (MODE == 2 ? 2 : 1); ++pass) {
            for (int item = tid; item < 1024; item += NTHR) {
                const int rl = item >> 2, wc = item & 3; float part = 0.f;
                const bf16_t* ar = (const bf16_t*)(u.a + (size_t)rl * lda);
                float tot = 0.f; if (MODE == 2 && pass == 1) tot = (xch[rl * 4] + xch[rl * 4 + 1]) + (xch[rl * 4 + 2] + xch[rl * 4 + 3]);
                for (int q = 0; q < (MODE == 3 ? 4 : 8); ++q) {
                    const int bj = q >> 2, fq = q & 3, cl = (MODE == 3 ? 0 : bj * 128) + wc * 32 + fq * 8;
                    float v[8], v2[8];
                    for (int i = 0; i < 8; ++i) { const bf16_t* br = (const bf16_t*)(u.b + (size_t)(cl + i) * ldb); float s = 0.f;
                        for (int k = 0; k < K; ++k) s += bf2f(ar[k]) * bf2f(br[k]); v[i] = s; }
                    if (MODE == 3) { for (int i = 0; i < 8; ++i) { const bf16_t* br = (const bf16_t*)(u.b + (size_t)(128 + cl + i) * ldb); float s = 0.f;
                        for (int k = 0; k < K; ++k) s += bf2f(ar[k]) * bf2f(br[k]); v2[i] = s; } }
                    if constexpr (MODE == 0) fun.store(u, rl, cl, v);
                    else if constexpr (MODE == 1) part += fun.store(u, rl, cl, v);
                    else if constexpr (MODE == 2) { part += fun.part(u, rl, cl, v); if (pass == 1) fun.store2(u, rl, cl, v, tot); }
                    else fun.store_pair(u, rl, cl, v, v2);
                }
                if constexpr (MODE == 1) fun.rowpart(u, rl, wc, part);
                if (MODE == 2 && pass == 0) xch[rl * 4 + wc] = part;
            }
            __syncthreads();
        }
    }
}

struct RegSched {
    const char* A; const char* B; size_t tA, tB; int nM, nN, nwg, G, c;
    __device__ __forceinline__ void init(const void* A_, int lda, const void* B_, int ldb, int nM_, int nN_, int G_, int c_) {
        A = (const char*)A_; B = (const char*)B_; tA = (size_t)256 * lda; tB = (size_t)256 * ldb; nM = nM_; nN = nN_; nwg = nM_ * nN_; G = G_; c = c_; }
    __device__ __forceinline__ bool next(int i, Unit& u) const {
        const long L = (long)i * G + c; if (L >= nwg) return false;
        int wgid = (int)L; { const int q = nwg / 8, r = nwg % 8, xcd = wgid % 8, off = wgid / 8; wgid = (xcd < r ? xcd * (q + 1) : r * (q + 1) + (xcd - r) * q) + off; }
        const int nig = 8 * nN, gid = wgid / nig, fm = gid * 8, gsz = (nM - fm) < 8 ? (nM - fm) : 8;
        u.pm = fm + ((wgid % nig) % gsz); u.pn = (wgid % nig) / gsz; u.z = 0;
        u.a = A + (size_t)u.pm * tA; u.b = B + (size_t)u.pn * tB; return true; }
};
template <class Map> struct MapSched {
    Map map; int nunits, G, c;
    __device__ __forceinline__ bool next(int i, Unit& u) const { const int L = i * G + c; if (L >= nunits) return false; map(L, u); return true; }
};
struct MapX { const char* up; const char* emat;
    __device__ __forceinline__ void operator()(int L, Unit& u) const { const int g = L >> 3, pm = L & 7; u.pm = pm; u.pn = 0; u.z = g;
        u.a = up + (size_t)g * 768 + (size_t)pm * 256 * 24576; u.b = emat + (size_t)g * 131072; } };
struct MapY { const char* up; const char* t16o;
    __device__ __forceinline__ void operator()(int L, Unit& u) const { const int g = L >> 3, pm = L & 7; u.pm = pm; u.pn = 0; u.z = g;
        u.a = up + (size_t)g * 768 + (size_t)pm * 256 * 24576; u.b = t16o + (size_t)g * 196608; } };
struct MapProjN { const char* xcm; const char* w; int acol;
    __device__ __forceinline__ void operator()(int L, Unit& u) const { const int x = L & 7, r = L >> 3, pm = (r >> 2) * 8 + x, h = r & 3; u.pm = pm; u.pn = 0; u.z = h;
        u.a = xcm + (size_t)pm * 256 * 4096 + acol + h * 512; u.b = w + (size_t)h * 131072; } };
struct MapProjT { const char* xcm; const char* w; int acol;
    __device__ __forceinline__ void operator()(int L, Unit& u) const { const int x = L & 7, r = L >> 3, pn = (r >> 2) * 8 + x, h = r & 3; u.pm = 0; u.pn = pn; u.z = h;
        u.a = w + (size_t)h * 131072; u.b = xcm + (size_t)pn * 256 * 4096 + acol + h * 512; } };
struct MapU1 { const char* q; const char* k;
    __device__ __forceinline__ void operator()(int L, Unit& u) const { const int z = L, c = z & 31, bh = z >> 5, h = bh & 3, b = bh >> 2; u.pm = 0; u.pn = 0; u.z = z;
        const size_t off = (size_t)(b * SEQ + c * LC) * 2048 + h * 512; u.a = q + off; u.b = k + off; } };
struct MapU2 { const char* vwt; const char* kt;
    __device__ __forceinline__ void operator()(int L, Unit& u) const { const int z = L, c = z & 31, bh = z >> 5, h = bh & 3, b = bh >> 2; u.pm = 0; u.pn = 0; u.z = z;
        const size_t off = (size_t)(h * 256) * 65536 + (size_t)(b * SEQ + c * LC) * 2; u.a = vwt + off; u.b = kt + off; } };
struct MapU4 { const char* sq; const char* vc;
    __device__ __forceinline__ void operator()(int L, Unit& u) const { const int z = L, c = z & 31, bh = z >> 5, h = bh & 3, b = bh >> 2; u.pm = 0; u.pn = 0; u.z = z;
        u.a = sq + ((size_t)(b * SEQ + c * LC) * 4 + h) * 1024; u.b = vc + (size_t)z * 262144; } };

struct FG1 { const float* rstd; bf16_t* xcm; bf16_t* sigo; bf16_t* up; bf16_t* gate; const float* bgate;
    __device__ __forceinline__ void begin(const Unit&) {}
    __device__ __forceinline__ void store(const Unit& u, int rl, int cl, float (&v)[8]) const {
        const int row = u.pm * 256 + rl, col = u.pn * 256 + cl; const float r = rstd[row];
#pragma unroll
        for (int i = 0; i < 8; ++i) v[i] *= r;
        if (col < 1024) st8bf(xcm + (size_t)row * 2048 + 1024 + col, v);
        else if (col < 2048) {
#pragma unroll
            for (int i = 0; i < 8; ++i) v[i] = sigmoidf_(v[i]);
            st8bf(sigo + (size_t)row * 1024 + (col - 1024), v); }
        else if (col < 2560) { const int ch = col - 2048, g = ch >> 4, cp = ch & 15, J = row >> 4, s = row & 15; st8bf(up + ((size_t)J * 32 + g) * 384 + s * 16 + cp, v); }
        else { const int gc = col - 2560; float b[8]; ld8f(bgate + gc, b);
#pragma unroll
            for (int i = 0; i < 8; ++i) v[i] = sigmoidf_(v[i] + b[i]);
            st8bf(gate + (size_t)row * 4096 + gc, v); }
    } };
struct FGates { float* graw;
    __device__ __forceinline__ void begin(const Unit&) {}
    __device__ __forceinline__ void store(const Unit& u, int rl, int cl, float (&v)[8]) const { if (cl < 16) st8f(graw + (size_t)(u.pm * 256 + rl) * 16 + cl, v); } };
struct FX { float* e;
    __device__ __forceinline__ void begin(const Unit&) {}
    __device__ __forceinline__ void store(const Unit& u, int rl, int cl, float (&v)[8]) const { if (cl < 128) st8f(e + ((size_t)(u.pm * 256 + rl) * 32 + u.z) * 128 + cl, v); } };
struct FQ { bf16_t* q; bf16_t* sq; const float* tpm; const LAS float* tab; float mc;
    __device__ __forceinline__ void begin(const Unit& u) { mc = tab[((u.pm >> 5) * 4 + u.z) * 32 + (u.pm & 31)]; }
    __device__ __forceinline__ void store(const Unit& u, int rl, int cl, float (&v)[8]) const {
        const int row = u.pm * 256 + rl, h = u.z; st8bf(q + (size_t)row * 1024 + h * 256 + cl, v);
        const float w = __expf(mc - fmaxf(mc, tpm[(size_t)h * M + row]));
#pragma unroll
        for (int i = 0; i < 8; ++i) v[i] *= w;
        st8bf(sq + ((size_t)row * 4 + h) * 512 + 256 + cl, v); } };
struct FK { bf16_t* k;
    __device__ __forceinline__ void begin(const Unit&) {}
    __device__ __forceinline__ void store(const Unit& u, int rl, int cl, float (&v)[8]) const { st8bf(k + (size_t)(u.pm * 256 + rl) * 1024 + u.z * 256 + cl, v); } };
struct FKT { bf16_t* kt; float* nlp; const float* ta; const LAS float* tab; float amax;
    __device__ __forceinline__ void begin(const Unit& u) { amax = tab[512 + ((u.pn >> 5) * 4 + u.z) * 32 + (u.pn & 31)]; }
    __device__ __forceinline__ float store(const Unit& u, int rl, int cl, float (&v)[8]) const {
        const int h = u.z, tok = u.pn * 256 + cl; st8bf(kt + (size_t)(h * 256 + rl) * M + tok, v);
        float a[8]; ld8f(ta + (size_t)h * M + tok, a); float s = 0.f;
#pragma unroll
        for (int i = 0; i < 8; ++i) s += v[i] * __expf(a[i] - amax);
        return s; }
    __device__ __forceinline__ void rowpart(const Unit& u, int rl, int wc, float part) const { const int zc = ((u.pn >> 5) * 4 + u.z) * 32 + (u.pn & 31); nlp[((size_t)zc * 256 + rl) * 4 + wc] = part; } };
struct FVT { bf16_t* vc; bf16_t* vwt; const float* ta; const LAS float* tab; float amax;
    __device__ __forceinline__ void begin(const Unit& u) { amax = tab[512 + ((u.pn >> 5) * 4 + u.z) * 32 + (u.pn & 31)]; }
    __device__ __forceinline__ void store(const Unit& u, int rl, int cl, float (&v)[8]) const {
        const int h = u.z, tok = u.pn * 256 + cl, zc = ((u.pn >> 5) * 4 + h) * 32 + (u.pn & 31);
        st8bf(vc + ((size_t)zc * 256 + rl) * 512 + cl, v);
        float a[8]; ld8f(ta + (size_t)h * M + tok, a);
#pragma unroll
        for (int i = 0; i < 8; ++i) v[i] *= __expf(a[i] - amax);
        st8bf(vwt + (size_t)(h * 256 + rl) * M + tok, v); } };
struct FU1 { bf16_t* sq; float* denp; const float* ta; const float* tpm; const LAS float* tab; float mc;
    __device__ __forceinline__ void begin(const Unit& u) { mc = tab[u.z]; }
    __device__ __forceinline__ float store(const Unit& u, int rl, int cl, float (&v)[8]) const {
        const int c = u.z & 31, bh = u.z >> 5, h = bh & 3, b = bh >> 2, row0 = b * SEQ + c * LC, row = row0 + rl;
        const float Mt = fmaxf(mc, tpm[(size_t)h * M + row]); float a[8]; ld8f(ta + (size_t)h * M + row0 + cl, a); float s = 0.f;
#pragma unroll
        for (int i = 0; i < 8; ++i) { const float x = (cl + i <= rl) ? bfround(v[i] * __expf(a[i] - Mt)) : 0.f; v[i] = x; s += x; }
        st8bf(sq + ((size_t)row * 4 + h) * 512 + cl, v); return s; }
    __device__ __forceinline__ void rowpart(const Unit& u, int rl, int wc, float part) const {
        const int c = u.z & 31, bh = u.z >> 5, h = bh & 3, b = bh >> 2, row = b * SEQ + c * LC + rl; denp[((size_t)h * M + row) * 4 + wc] = part; } };
struct FU2 { bf16_t* dcl;
    __device__ __forceinline__ void begin(const Unit&) {}
    __device__ __forceinline__ void store(const Unit& u, int rl, int cl, float (&v)[8]) const { st8bf(dcl + ((size_t)u.z * 256 + rl) * 256 + cl, v); } };
struct FY { const bf16_t* up; bf16_t* ysp; const float* dvec;
    __device__ __forceinline__ void begin(const Unit&) {}
    __device__ __forceinline__ void store(const Unit& u, int rl, int cl, float (&v)[8]) const {
        const int g = u.z, J = u.pm * 256 + rl, t = cl >> 4, c0 = cl & 15, tok = J * 16 + t, ch = g * 16 + c0;
        float uu[8], d[8]; ld8bf(up + ((size_t)J * 32 + g) * 384 + t * 16 + c0, uu); ld8f(dvec + ch, d);
#pragma unroll
        for (int i = 0; i < 8; ++i) { const float y = v[i] + d[i] * uu[i]; v[i] = y * sigmoidf_(1.5957691216f * (y + 0.044715f * y * y * y)); }
        st8bf(ysp + (size_t)tok * 512 + ch, v); } };
struct FG5 { const bf16_t* ysp; bf16_t* ys; const float* bglu;
    __device__ __forceinline__ void begin(const Unit&) {}
    __device__ __forceinline__ void store(const Unit& u, int rl, int cl, float (&v)[8]) const {
        const int row = u.pm * 256 + rl, col = u.pn * 256 + cl; float y[8], b[8]; ld8bf(ysp + (size_t)row * 512 + col, y); ld8f(bglu + col, b);
#pragma unroll
        for (int i = 0; i < 8; ++i) v[i] = y[i] * sigmoidf_(v[i] + b[i]);
        st8bf(ys + (size_t)row * 512 + col, v); } };
struct FU4 { const float* rdn; const bf16_t* sigo; const bf16_t* xcm; const float* mhg; const float* skip; bf16_t* outm;
    __device__ __forceinline__ void begin(const Unit&) {}
    __device__ __forceinline__ float part(const Unit& u, int rl, int cl, float (&v)[8]) const {
        const int c = u.z & 31, bh = u.z >> 5, h = bh & 3, b = bh >> 2, row = b * SEQ + c * LC + rl; const float r = rdn[(size_t)h * M + row]; float s = 0.f;
#pragma unroll
        for (int i = 0; i < 8; ++i) { v[i] *= r; s += v[i] * v[i]; }
        return s; }
    __device__ __forceinline__ void store2(const Unit& u, int rl, int cl, float (&v)[8], float tot) const {
        const int c = u.z & 31, bh = u.z >> 5, h = bh & 3, b = bh >> 2, row = b * SEQ + c * LC + rl, col = h * 256 + cl;
        const float rs = rsqrtf(tot * (1.f / 256.f) + EPS); float so[8], xc[8], g[8], sk[8];
        ld8bf(sigo + (size_t)row * 1024 + col, so); ld8bf(xcm + (size_t)row * 2048 + col, xc); ld8f(mhg + col, g); ld8f(skip + col, sk);
#pragma unroll
        for (int i = 0; i < 8; ++i) v[i] = so[i] * (v[i] * rs * g[i] + sk[i] * xc[i]);
        st8bf(outm + (size_t)row * 1024 + col, v); } };
struct FG6 { const bf16_t* gate; bf16_t* tmp;
    __device__ __forceinline__ void begin(const Unit&) {}
    __device__ __forceinline__ void store(const Unit& u, int rl, int cl, float (&v)[8]) const {
        const int row = u.pm * 256 + rl, col = u.pn * 256 + cl; float g[8]; ld8bf(gate + (size_t)row * 4096 + 2048 + col, g);
#pragma unroll
        for (int i = 0; i < 8; ++i) v[i] *= g[i];
        st8bf(tmp + (size_t)row * 2048 + col, v); } };
struct FG4 { const bf16_t* gate; const bf16_t* tmp; bf16_t* merged;
    __device__ __forceinline__ void begin(const Unit&) {}
    __device__ __forceinline__ void store(const Unit& u, int rl, int cl, float (&v)[8]) const {
        const int row = u.pm * 256 + rl, col = u.pn * 256 + cl; float g[8], t[8]; ld8bf(gate + (size_t)row * 4096 + col, g); ld8bf(tmp + (size_t)row * 2048 + col, t);
#pragma unroll
        for (int i = 0; i < 8; ++i) v[i] = v[i] * g[i] + t[i];
        st8bf(merged + (size_t)row * 2048 + col, v); } };
struct FG7 { const float* x; float* x1; bf16_t* x1b; float* ssq;
    __device__ __forceinline__ void begin(const Unit&) {}
    __device__ __forceinline__ float store(const Unit& u, int rl, int cl, float (&v)[8]) const {
        const int row = u.pm * 256 + rl, col = u.pn * 256 + cl; float xx[8]; ld8f(x + (size_t)row * 2048 + col, xx); float s = 0.f;
#pragma unroll
        for (int i = 0; i < 8; ++i) { v[i] += xx[i]; s += v[i] * v[i]; }
        st8f(x1 + (size_t)row * 2048 + col, v); st8bf(x1b + (size_t)row * 2048 + col, v); return s; }
    __device__ __forceinline__ void rowpart(const Unit& u, int rl, int wc, float part) const { atomicAdd(ssq + u.pm * 256 + rl, part); } };
struct FG8 { const float* ssq; bf16_t* hb;
    __device__ __forceinline__ void begin(const Unit&) {}
    __device__ __forceinline__ void store_pair(const Unit& u, int rl, int cl, float (&vg)[8], float (&vu)[8]) const {
        const int row = u.pm * 256 + rl; const float r = rsqrtf(ssq[row] * (1.f / 2048.f) + EPS);
#pragma unroll
        for (int i = 0; i < 8; ++i) { const float g = vg[i] * r; vg[i] = g * sigmoidf_(g) * (vu[i] * r); }
        st8bf(hb + (size_t)row * FF + u.pn * 128 + cl, vg); } };
struct FG9 { float* x1; float* ssq;
    __device__ __forceinline__ void begin(const Unit&) {}
    __device__ __forceinline__ float store(const Unit& u, int rl, int cl, float (&v)[8]) const {
        const int row = u.pm * 256 + rl, col = u.pn * 256 + cl; float xx[8]; ld8f(x1 + (size_t)row * 2048 + col, xx); float s = 0.f;
#pragma unroll
        for (int i = 0; i < 8; ++i) { v[i] += xx[i]; s += v[i] * v[i]; }
        st8f(x1 + (size_t)row * 2048 + col, v); return s; }
    __device__ __forceinline__ void rowpart(const Unit& u, int rl, int wc, float part) const { atomicAdd(ssq + u.pm * 256 + rl, part); } };

#define XB_TMO      128
#define XB_XCNT(j)  (256  + 64 * (j))
#define XB_XSUB(j)  (1280 + 64 * (j))
#define XB_XGEN(j)  (2304 + 64 * (j))
#define XB_TOP      3328
#define XB_TOPGEN   3392
#define XCD_BAR_WORDS 3456
#define XB_SPIN_CAP (1u << 18)
__device__ __forceinline__ unsigned xb_ld(unsigned* p)              { return __hip_atomic_load(p, __ATOMIC_RELAXED, __HIP_MEMORY_SCOPE_AGENT); }
__device__ __forceinline__ unsigned xb_add(unsigned* p, unsigned v) { return __hip_atomic_fetch_add(p, v, __ATOMIC_RELAXED, __HIP_MEMORY_SCOPE_AGENT); }
__device__ __forceinline__ unsigned xb_xcc_id() { return (unsigned)__builtin_amdgcn_s_getreg((3 << 11) | 20) & 0xFu; }
#define XB_SPIN(cond, bar) do { unsigned _sp = 0; while (cond) { __builtin_amdgcn_s_sleep(1); \
    if ((++_sp & 255u) == 0u) { if (xb_ld(&(bar)[XB_TMO])) break; if (_sp > XB_SPIN_CAP) { atomicAdd(&(bar)[XB_TMO], 1u); break; } } } } while (0)
struct XcdBarrier { unsigned* bar; unsigned x; volatile LAS unsigned* st; };
__device__ __forceinline__ XcdBarrier xcd_barrier_post(unsigned* bar, volatile LAS unsigned* st) {
    XcdBarrier b; b.bar = bar; b.x = xb_xcc_id(); b.st = st;
    if (threadIdx.x == 0) (void)xb_add(&bar[XB_XCNT(b.x)], 1u);
    return b;
}
__device__ __forceinline__ void xcd_barrier_complete(unsigned* bar, unsigned x, unsigned& nloc, unsigned& nx) {
    const unsigned G = gridDim.x * gridDim.y * gridDim.z;
    unsigned sum, cnt, mine, sp = 0u;
    for (;;) {
        sum = 0u; cnt = 0u; mine = 0u;
#pragma unroll
        for (unsigned j = 0; j < 16; ++j) { const unsigned c = xb_ld(&bar[XB_XCNT(j)]); sum += c; cnt += (c > 0u) ? 1u : 0u; mine = (j == x) ? c : mine; }
        if (sum == G) break;
        __builtin_amdgcn_s_sleep(1);
        if ((++sp & 255u) == 0u) { if (xb_ld(&bar[XB_TMO])) break; if (sp > XB_SPIN_CAP) { atomicAdd(&bar[XB_TMO], 1u); break; } }
    }
    nloc = mine > 0u ? mine : 1u; nx = cnt > 0u ? cnt : 1u;
}
__device__ __forceinline__ void xcd_barrier(const XcdBarrier& b) {
    asm volatile("s_waitcnt vmcnt(0)" ::: "memory");
    __syncthreads();
    if (threadIdx.x == 0) {
        unsigned* bar = b.bar;
        __builtin_amdgcn_s_waitcnt(0);
        unsigned nloc = b.st[0], nx = b.st[1];
        if (nloc == 0u) { xcd_barrier_complete(bar, b.x, nloc, nx); b.st[0] = nloc; b.st[1] = nx; }
        const unsigned old = xb_add(&bar[XB_XSUB(b.x)], 1u);
        const unsigned gen = old / nloc;
        if (old + 1u == (gen + 1u) * nloc) {
            __builtin_amdgcn_fence(__ATOMIC_RELEASE, "agent");
            asm volatile("s_waitcnt vmcnt(0)" ::: "memory");
            const unsigned og = xb_add(&bar[XB_TOP], 1u);
            const unsigned tg = og / nx;
            if (og + 1u == (tg + 1u) * nx) xb_add(&bar[XB_TOPGEN], 1u);
            else XB_SPIN(xb_ld(&bar[XB_TOPGEN]) == tg, bar);
            __builtin_amdgcn_fence(__ATOMIC_ACQUIRE, "agent");
            xb_add(&bar[XB_XGEN(b.x)], 1u);
            asm volatile("s_waitcnt vmcnt(0)" ::: "memory");
        } else {
            XB_SPIN(xb_ld(&bar[XB_XGEN(b.x)]) == gen, bar);
            __builtin_amdgcn_fence(__ATOMIC_ACQUIRE, "agent");
            asm volatile("s_waitcnt vmcnt(0)" ::: "memory");
        }
    }
    __syncthreads();
}

constexpr int RING_BYTES = 131072;
constexpr int XCH_OFF = RING_BYTES;
constexpr int TAB_OFF = RING_BYTES + 4096;
constexpr int MISC_OFF = RING_BYTES + 8192;
constexpr int LDS_BYTES = 147456;

#define CAS __attribute__((address_space(4)))
struct Args { const float* in[31]; float* out; unsigned char* ws; int ph_lo, ph_hi; };
__device__ __forceinline__ const CAS Args* kargs() { const CAS Args* p = (const CAS Args*)__builtin_amdgcn_kernarg_segment_ptr(); asm volatile("" : "+s"(p)); return p; }
struct Ctx { const CAS Args* A; unsigned char* ws; int G, tid, lane, wid; LAS unsigned char* lds; };
__device__ __forceinline__ Ctx make_ctx(LAS unsigned char* lds) { Ctx C; C.A = kargs(); C.ws = C.A->ws; C.G = gridDim.x; int t = threadIdx.x; asm volatile("" : "+v"(t)); C.tid = t; C.lane = t & 63; C.wid = __builtin_amdgcn_readfirstlane(t >> 6); C.lds = lds; return C; }
#define WSP(T, off) ((T*)(C.ws + (off)))

__device__ __forceinline__ void p0_tr(const Ctx& C, const float* W, int Kd, int Nd, bf16_t* T, const float* ksc, float mul, int blk, int tstride, int toff) {
    const int gt = blockIdx.x * NTHR + C.tid, gs = C.G * NTHR; const int items = (Kd / 8) * Nd;
    for (int it = gt; it < items; it += gs) { const int n = it % Nd, k0 = (it / Nd) * 8; float v[8];
#pragma unroll
        for (int j = 0; j < 8; ++j) v[j] = W[(size_t)(k0 + j) * Nd + n] * (ksc ? ksc[k0 + j] : 1.f) * mul;
        const int tr = (n / blk) * tstride + toff + n % blk; st8bf(T + (size_t)tr * Kd + k0, v); }
}
__device__ __forceinline__ void s5_apow(const float* are, const float* aim, const float* lstep, int g, int p, float n, float& re, float& im) {
    const float st = expf(lstep[g]) * n, mag = expf(are[g * 64 + p] * st), ang = aim[g * 64 + p] * st; float s, c; sincosf(ang, &s, &c); re = mag * c; im = mag * s; }
__device__ __forceinline__ void s5_kappa(const float* are, const float* aim, const float* lstep, int g, int p, float& kr, float& ki) {
    float ar, ai; s5_apow(are, aim, lstep, g, p, 1.f, ar, ai); const float x = ar - 1.f, y = ai, u = are[g * 64 + p], v = aim[g * 64 + p], d = 1.f / (u * u + v * v);
    kr = (x * u + y * v) * d; ki = (y * u - x * v) * d; }

__device__ __forceinline__ void phase_prologue(LAS unsigned char* lds_) {
    const Ctx C = make_ctx(lds_); const CAS Args* A = C.A; const int gt = blockIdx.x * NTHR + C.tid, gs = C.G * NTHR;
    p0_tr(C, A->in[2], 2048, INC, WSP(bf16_t, WS_WIN), A->in[1], 1.f, INC, 0, 0);
    for (int h = 0; h < 4; ++h) {
        p0_tr(C, A->in[5] + h * 65536, 256, 256, WSP(bf16_t, WS_WQ) + h * 65536, nullptr, 1.f, 256, 0, 0);
        p0_tr(C, A->in[6] + h * 65536, 256, 256, WSP(bf16_t, WS_WK) + h * 65536, nullptr, 0.0625f, 256, 0, 0);
        p0_tr(C, A->in[7] + h * 65536, 256, 256, WSP(bf16_t, WS_WV) + h * 65536, nullptr, 1.f, 256, 0, 0); }
    p0_tr(C, A->in[12], 1024, 2048, WSP(bf16_t, WS_WUPM), nullptr, 1.f, 2048, 0, 0);
    p0_tr(C, A->in[23], 512, 2048, WSP(bf16_t, WS_WUPS), nullptr, 1.f, 2048, 0, 0);
    p0_tr(C, A->in[21], 512, 512, WSP(bf16_t, WS_WGLU), nullptr, 1.f, 512, 0, 0);
    p0_tr(C, A->in[25], 2048, 2048, WSP(bf16_t, WS_WOUT), nullptr, 1.f, 2048, 0, 0);
    p0_tr(C, A->in[27], 2048, FF, WSP(bf16_t, WS_WGU), A->in[26], 1.f, 128, 256, 0);
    p0_tr(C, A->in[28], 2048, FF, WSP(bf16_t, WS_WGU), A->in[26], 1.f, 128, 256, 128);
    p0_tr(C, A->in[29], FF, 2048, WSP(bf16_t, WS_WD), nullptr, 1.f, 2048, 0, 0);
    { bf16_t* wg = WSP(bf16_t, WS_WG); const float* wq = A->in[5]; const float* wk = A->in[6]; const float* wv = A->in[7]; const float* wif = A->in[8];
      for (int it = gt; it < 2048 * 8; it += gs) { const int o = it & 7, k = it >> 3; float s = 0.f;
          if (k < 1024) { const int h = k >> 8, d = k & 255; const float* rq = wq + (size_t)(h * 256 + d) * 256; const float* rk = wk + (size_t)(h * 256 + d) * 256;
              for (int e = 0; e < 256; ++e) s += rq[e] * wif[(size_t)(h * 256 + e) * 8 + o] + 0.0625f * rk[e] * wif[(size_t)(1024 + h * 256 + e) * 8 + o]; }
          else { const int kk = k - 1024, h = kk >> 8, d = kk & 255; const float* rv = wv + (size_t)(h * 256 + d) * 256;
              for (int e = 0; e < 256; ++e) s += rv[e] * wif[(size_t)(2048 + h * 256 + e) * 8 + o]; }
          const float hi = bfround(s); wg[(size_t)o * 2048 + k] = f2bf(hi); wg[(size_t)(o + 8) * 2048 + k] = f2bf(s - hi); }
      for (int it = gt; it < 240 * 256; it += gs) { u32x4 z = {0u, 0u, 0u, 0u}; *(u32x4*)(wg + (size_t)16 * 2048 + (size_t)it * 8) = z; } }
    { const float* are = A->in[13]; const float* aim = A->in[14]; const float* ls = A->in[15]; const float* bre = A->in[16]; const float* bim = A->in[17]; const float* cre = A->in[18]; const float* cim = A->in[19];
      bf16_t* em = WSP(bf16_t, WS_EMAT); bf16_t* t16 = WSP(bf16_t, WS_T16O);
      for (int it = gt; it < 32 * 128 * 16; it += gs) { const int s = it & 15, rp = (it >> 4) & 127, g = it >> 11, ri = rp >> 6, p = rp & 63;
          float pr, pi, kr, ki; s5_apow(are, aim, ls, g, p, (float)(15 - s), pr, pi); s5_kappa(are, aim, ls, g, p, kr, ki);
          const float cr = pr * kr - pi * ki, ci = pr * ki + pi * kr; float v[8];
#pragma unroll
          for (int hf = 0; hf < 2; ++hf) {
#pragma unroll
              for (int j = 0; j < 8; ++j) { const float br = bre[((size_t)g * 64 + p) * 16 + hf * 8 + j], bi = bim[((size_t)g * 64 + p) * 16 + hf * 8 + j]; v[j] = ri ? (cr * bi + ci * br) : (cr * br - ci * bi); }
              st8bf(em + ((size_t)g * 256 + rp) * 256 + s * 16 + hf * 8, v); } }
      for (int it = gt; it < 32 * 128 * 32; it += gs) { const int g = it >> 12, r = it & 4095; u32x4 z = {0u, 0u, 0u, 0u}; *(u32x4*)(em + ((size_t)g * 256 + 128) * 256 + (size_t)r * 8) = z; }
      for (int it = gt; it < 32 * 16 * 256; it += gs) { const int cp = it & 15, c = (it >> 4) & 15, lag = (it >> 8) & 15, g = it >> 12; float acc = 0.f;
          for (int p = 0; p < 64; ++p) { float pr, pi, kr, ki; s5_apow(are, aim, ls, g, p, (float)lag, pr, pi); s5_kappa(are, aim, ls, g, p, kr, ki);
              const float xr = pr * kr - pi * ki, xi = pr * ki + pi * kr;
              const float br = bre[((size_t)g * 64 + p) * 16 + cp], bi = bim[((size_t)g * 64 + p) * 16 + cp];
              const float yr = xr * br - xi * bi, yi = xr * bi + xi * br;
              acc += cre[((size_t)g * 16 + c) * 64 + p] * yr - cim[((size_t)g * 16 + c) * 64 + p] * yi; }
          const bf16_t w = f2bf(acc);
          for (int t = lag; t < 16; ++t) t16[((size_t)g * 256 + t * 16 + c) * 384 + (t - lag) * 16 + cp] = w; }
      for (int it = gt; it < 32 * 256 * 16; it += gs) { const int s = it & 15, row = (it >> 4) & 255, g = it >> 12, t = row >> 4;
          if (s > t) { u32x4 z = {0u, 0u, 0u, 0u}; bf16_t* d = t16 + ((size_t)g * 256 + row) * 384 + s * 16; *(u32x4*)d = z; *(u32x4*)(d + 8) = z; } }
      for (int it = gt; it < 32 * 256 * 64; it += gs) { const int p = it & 63, row = (it >> 6) & 255, g = it >> 14, t = row >> 4, c = row & 15;
          float pr, pi; s5_apow(are, aim, ls, g, p, (float)(t + 1), pr, pi); const float cr = cre[((size_t)g * 16 + c) * 64 + p], ci = cim[((size_t)g * 16 + c) * 64 + p];
          bf16_t* d = t16 + ((size_t)g * 256 + row) * 384 + 256; d[p] = f2bf(cr * pr - ci * pi); d[64 + p] = f2bf(-(cr * pi + ci * pr)); } }
    { const float* x = A->in[0]; bf16_t* xb = WSP(bf16_t, WS_XB); float* rs = WSP(float, WS_RSTD1);
      for (int row = blockIdx.x * NWAVES + C.wid; row < M; row += C.G * NWAVES) { const float* xr = x + (size_t)row * 2048; float s = 0.f;
#pragma unroll
          for (int j = 0; j < 4; ++j) { float v[8]; ld8f(xr + j * 512 + C.lane * 8, v);
#pragma unroll
              for (int i = 0; i < 8; ++i) s += v[i] * v[i];
              st8bf(xb + (size_t)row * 2048 + j * 512 + C.lane * 8, v); }
          s = wave_sum(s); if (C.lane == 0) rs[row] = rsqrtf(s * (1.f / 2048.f) + EPS); } }
    { float* z2 = WSP(float, WS_SSQ2); float* z3 = WSP(float, WS_SSQ3); for (int i = gt; i < M; i += gs) { z2[i] = 0.f; z3[i] = 0.f; } }
}

__device__ __forceinline__ void build_mtab(LAS unsigned char* lds_) {
    const Ctx C = make_ctx(lds_);
    const float* cs = WSP(float, WS_CS); LAS float* tab = (LAS float*)(C.lds + TAB_OFF);
    for (int bh = C.wid; bh < 16; bh += NWAVES) { float bl = 0.f, am = 0.f;
        if (C.lane < 32) { bl = cs[(bh * 32 + C.lane) * 2]; am = cs[(bh * 32 + C.lane) * 2 + 1]; }
        float m = 0.f;
        for (int c = 0; c < 32; ++c) { const float blc = __shfl(bl, c), amc = __shfl(am, c); if (C.lane == 0) { tab[bh * 32 + c] = m; tab[512 + bh * 32 + c] = amc; } m = blc + fmaxf(m, amc); } }
    __syncthreads();
}

__device__ __forceinline__ void phase_conv(LAS unsigned char* lds_) {
    const Ctx C = make_ctx(lds_);
    bf16_t* xcm = WSP(bf16_t, WS_XCM); const float* cw = C.A->in[3]; const float* cb = C.A->in[4];
    const int gt = blockIdx.x * NTHR + C.tid, gs = C.G * NTHR;
    for (int it = gt; it < M * 128; it += gs) { const int c8 = it & 127, row = it >> 7, t = row & (SEQ - 1), ch = c8 * 8; float y[8]; ld8f(cb + ch, y);
#pragma unroll
        for (int j = 0; j < 4; ++j) { if (t - 3 + j >= 0) { float xv[8], w[8]; ld8bf(xcm + (size_t)(row - 3 + j) * 2048 + 1024 + ch, xv); ld8f(cw + j * 1024 + ch, w);
#pragma unroll
                for (int i = 0; i < 8; ++i) y[i] += xv[i] * w[i]; } }
#pragma unroll
        for (int i = 0; i < 8; ++i) y[i] = y[i] * sigmoidf_(y[i]);
        st8bf(xcm + (size_t)row * 2048 + ch, y); }
}

__device__ __forceinline__ void phase_scans(LAS unsigned char* lds_) {
    const Ctx C = make_ctx(lds_);
    const float* graw = WSP(float, WS_GRAW); const float* bif = C.A->in[9];
    float* ta = WSP(float, WS_TA); float* tb = WSP(float, WS_TB); float* tpm = WSP(float, WS_TPM); float* cs = WSP(float, WS_CS);
    const int gw = blockIdx.x * NWAVES + C.wid, lane = C.lane;
    if (gw < 512) { const int z = gw, c = z & 31, bh = z >> 5, h = bh & 3, b = bh >> 2, row0 = b * SEQ + c * LC + lane * 4;
        const float bi = bif[h], bfg = bif[4 + h]; float li[4], bb[4], aa[4], pm[4]; float run = 0.f;
#pragma unroll
        for (int i = 0; i < 4; ++i) { const float* g = graw + (size_t)(row0 + i) * 16; li[i] = g[h] + g[8 + h] + bi; const float gf = g[4 + h] + g[12 + h] + bfg;
            const float lf = fminf(gf, 0.f) - log1pf(expf(-fabsf(gf))); run += lf; bb[i] = run; }
        float incl = run;
#pragma unroll
        for (int o = 1; o < 64; o <<= 1) { const float t = __shfl_up(incl, o); if (lane >= o) incl += t; }
        const float excl = incl - run; float mx = -INFINITY;
#pragma unroll
        for (int i = 0; i < 4; ++i) { bb[i] += excl; aa[i] = li[i] - bb[i]; mx = fmaxf(mx, aa[i]); pm[i] = mx; }
        float imx = mx;
#pragma unroll
        for (int o = 1; o < 64; o <<= 1) { const float t = __shfl_up(imx, o); if (lane >= o) imx = fmaxf(imx, t); }
        float emx = __shfl_up(imx, 1); if (lane == 0) emx = -INFINITY;
#pragma unroll
        for (int i = 0; i < 4; ++i) pm[i] = fmaxf(pm[i], emx);
        const size_t o4 = (size_t)h * M + row0;
        *(f32x4*)(ta + o4) = (f32x4){aa[0], aa[1], aa[2], aa[3]}; *(f32x4*)(tb + o4) = (f32x4){bb[0], bb[1], bb[2], bb[3]}; *(f32x4*)(tpm + o4) = (f32x4){pm[0], pm[1], pm[2], pm[3]};
        if (lane == 63) { cs[z * 2] = bb[3]; cs[z * 2 + 1] = pm[3]; }
    } else {
        const int ts = (gw - 512) * 64 + lane;
        if (ts < BATCH * NG * SP) { const int p = ts & 63, g = (ts >> 6) & 31, b = ts >> 11; const float* e = WSP(float, WS_E); bf16_t* up = WSP(bf16_t, WS_UP);
            float ar, ai; s5_apow(C.A->in[13], C.A->in[14], C.A->in[15], g, p, 16.f, ar, ai); float sr = 0.f, si = 0.f;
            for (int j0 = 0; j0 < 512; j0 += 8) { float er[8], ei[8];
#pragma unroll
                for (int j = 0; j < 8; ++j) { const size_t o = ((size_t)(b * 512 + j0 + j) * 32 + g) * 128; er[j] = e[o + p]; ei[j] = e[o + 64 + p]; }
#pragma unroll
                for (int j = 0; j < 8; ++j) { bf16_t* d = up + ((size_t)(b * 512 + j0 + j) * 32 + g) * 384 + 256; d[p] = f2bf(sr); d[64 + p] = f2bf(si);
                    const float nr = ar * sr - ai * si + er[j], ni = ar * si + ai * sr + ei[j]; sr = nr; si = ni; } } }
    }
}

__device__ __forceinline__ void phase_state(LAS unsigned char* lds_) {
    const Ctx C = make_ctx(lds_);
    const float* cs = WSP(float, WS_CS); const bf16_t* dcl = WSP(bf16_t, WS_DCL); bf16_t* vc = WSP(bf16_t, WS_VC);
    LAS float* tab = (LAS float*)(C.lds + TAB_OFF);
    LAS float* nst = (LAS float*)(C.lds);
    const int w = blockIdx.x, bh = w >> 4, sl = w & 15, h = bh & 3, b = bh >> 2, tid = C.tid;
    if (w >= 256) return;
    if (tid < 64) { float bl = 0.f, am = 0.f; if (tid < 32) { bl = cs[(bh * 32 + tid) * 2]; am = cs[(bh * 32 + tid) * 2 + 1]; }
        float m = 0.f;
        for (int c = 0; c < 32; ++c) { const float blc = __shfl(bl, c), amc = __shfl(am, c), mx = fmaxf(m, amc);
            if (tid == 0) { tab[c * 4] = __expf(m - mx); tab[c * 4 + 1] = __expf(amc - mx); tab[c * 4 + 2] = m; }
            m = blc + mx; } }
    __syncthreads();
    if (tid < 256) { const float* nlp = WSP(float, WS_NLP); float n = 0.f;
        for (int c = 0; c < 2 * sl + 1; ++c) { if (c == 2 * sl) nst[tid] = n;
            const f32x4 pv = *(const f32x4*)(nlp + ((size_t)(bh * 32 + c) * 256 + tid) * 4); n = tab[c * 4] * n + tab[c * 4 + 1] * ((pv[0] + pv[1]) + (pv[2] + pv[3])); }
        if (sl == 0) nst[tid] = 0.f;
        nst[256 + tid] = n; }
    { const int off = sl * 4096 + tid * 8, e = off >> 8, j = off & 255; float cst[8];
#pragma unroll
      for (int i = 0; i < 8; ++i) cst[i] = 0.f;
      for (int c = 0; c < 32; ++c) { const size_t z = (size_t)bh * 32 + c; float d[8]; ld8bf(dcl + z * 65536 + off, d);
          st8bf(vc + (z * 256 + e) * 512 + 256 + j, cst);
          const float dc = tab[c * 4], sc = tab[c * 4 + 1];
#pragma unroll
          for (int i = 0; i < 8; ++i) cst[i] = dc * cst[i] + sc * d[i]; } }
    __syncthreads();
    { const int cl = tid >> 8, c = 2 * sl + cl, row = b * SEQ + c * LC + (tid & 255); const bf16_t* q = WSP(bf16_t, WS_Q) + (size_t)row * 1024 + h * 256; float qn = 0.f;
      for (int k = 0; k < 256; k += 8) { float qv[8]; ld8bf(q + k, qv);
#pragma unroll
          for (int i = 0; i < 8; ++i) qn += qv[i] * nst[cl * 256 + k + i]; }
      const float mc = tab[c * 4 + 2], Mt = fmaxf(mc, WSP(float, WS_TPM)[(size_t)h * M + row]), bt = WSP(float, WS_TB)[(size_t)h * M + row];
      const f32x4 dp = *(const f32x4*)(WSP(float, WS_DENP) + ((size_t)h * M + row) * 4);
      const float den = (dp[0] + dp[1]) + (dp[2] + dp[3]) + __expf(mc - Mt) * qn;
      WSP(float, WS_RDN)[(size_t)h * M + row] = 1.f / fmaxf(fabsf(den), __expf(-(bt + Mt))); }
}

__device__ __forceinline__ void phase_final(LAS unsigned char* lds_) {
    const Ctx C = make_ctx(lds_);
    float* out = C.A->out; const float* ssq = WSP(float, WS_SSQ3); const float* g = C.A->in[30];
    for (int row = blockIdx.x * NWAVES + C.wid; row < M; row += C.G * NWAVES) { const float r = rsqrtf(ssq[row] * (1.f / 2048.f) + EPS); float* o = out + (size_t)row * 2048;
#pragma unroll
        for (int j = 0; j < 4; ++j) { float v[8], gg[8]; ld8f(o + j * 512 + C.lane * 8, v); ld8f(g + j * 512 + C.lane * 8, gg);
#pragma unroll
            for (int i = 0; i < 8; ++i) v[i] = v[i] * r * gg[i];
            st8f(o + j * 512 + C.lane * 8, v); } }
}

#ifndef MK_N_LAUNCHES
#define MK_N_LAUNCHES 1
#endif
#ifndef NAIVE_MASK
#define NAIVE_MASK 0u
#endif
constexpr int NPH = 14;
constexpr int CW_BAR = 1024;
#ifndef JOB_MASK
#define JOB_MASK 0xffffffffu
#endif
#define GEMM(id, MODE, lda, ldb, K, S, f) do { if constexpr (!(((JOB_MASK) >> (id)) & 1u)) {} else if constexpr (((NAIVE_MASK) >> (id)) & 1u) gemm_naive<MODE>(lds, lda, ldb, K, S, f); else gemm_phase<MODE>(lds, lda, ldb, K, S, f); } while (0)

__global__ void __launch_bounds__(NTHR, 2) fwd_kernel(Args args) {
    extern __shared__ __attribute__((aligned(16))) unsigned char lds_raw[];
    LAS unsigned char* lds = (LAS unsigned char*)lds_raw;
    volatile LAS unsigned* MISC = (volatile LAS unsigned*)(lds + MISC_OFF);
    if (threadIdx.x < 32) MISC[threadIdx.x] = 0u;
    __syncthreads();
    XcdBarrier bar; bar.bar = (unsigned*)(args.ws + WS_CTL) + CW_BAR; bar.x = 0; bar.st = nullptr;
    if (MK_N_LAUNCHES == 1) bar = xcd_barrier_post((unsigned*)(args.ws + WS_CTL) + CW_BAR, MISC + 8);
    const int lo = args.ph_lo, hi = args.ph_hi;
#ifndef PH_MASK
#define PH_MASK 0xffffu
#endif
#define IN(k) ((((PH_MASK) >> (k)) & 1u) && lo <= (k) && (k) < hi)
#define SEAM(k) do { if (MK_N_LAUNCHES == 1) { if (IN(k) && IN((k) + 1)) xcd_barrier(bar); } } while (0)
#define W(T, off) ((T*)(ws + (off)))
#define PHASE_ARGS const CAS Args* A = kargs(); unsigned char* ws = A->ws; const int G = gridDim.x, bx = blockIdx.x; (void)ws; (void)G; (void)bx

    if (IN(0)) phase_prologue(lds);
    SEAM(0);
    if (IN(1)) { PHASE_ARGS; RegSched S; S.init(W(char, WS_XB), 4096, W(char, WS_WIN), 4096, 128, 26, G, bx);
        FG1 f{W(float, WS_RSTD1), W(bf16_t, WS_XCM), W(bf16_t, WS_SIGO), W(bf16_t, WS_UP), (bf16_t*)A->out, A->in[24]};
        GEMM(0, 0, 4096, 4096, 2048, S, f); }
    SEAM(1);
    if (IN(2)) phase_conv(lds);
    SEAM(2);
    if (IN(3)) { PHASE_ARGS;
        { RegSched S; S.init(W(char, WS_XCM), 4096, W(char, WS_WG), 4096, 128, 1, G, bx); FGates f{W(float, WS_GRAW)}; GEMM(1, 0, 4096, 4096, 2048, S, f); }
        { MapSched<MapX> S{{W(char, WS_UP), W(char, WS_EMAT)}, 256, G, bx}; FX f{W(float, WS_E)}; GEMM(2, 0, 24576, 512, 256, S, f); } }
    SEAM(3);
    if (IN(4)) phase_scans(lds);
    SEAM(4);
    if (IN(5)) { PHASE_ARGS; build_mtab(lds); const LAS float* mtab = (const LAS float*)(lds + TAB_OFF);
        { MapSched<MapProjN> S{{W(char, WS_XCM), W(char, WS_WQ), 0}, 512, G, bx}; FQ f{W(bf16_t, WS_Q), W(bf16_t, WS_SQ), W(float, WS_TPM), mtab, 0.f}; GEMM(3, 0, 4096, 512, 256, S, f); }
        { MapSched<MapProjN> S{{W(char, WS_XCM), W(char, WS_WK), 0}, 512, G, bx}; FK f{W(bf16_t, WS_K)}; GEMM(4, 0, 4096, 512, 256, S, f); }
        { MapSched<MapProjT> S{{W(char, WS_XCM), W(char, WS_WK), 0}, 512, G, bx}; FKT f{W(bf16_t, WS_KT), W(float, WS_NLP), W(float, WS_TA), mtab, 0.f}; GEMM(5, 1, 512, 4096, 256, S, f); }
        { MapSched<MapProjT> S{{W(char, WS_XCM), W(char, WS_WV), 2048}, 512, G, bx}; FVT f{W(bf16_t, WS_VC), W(bf16_t, WS_VWT), W(float, WS_TA), mtab, 0.f}; GEMM(6, 0, 512, 4096, 256, S, f); } }
    SEAM(5);
    if (IN(6)) { PHASE_ARGS; build_mtab(lds); const LAS float* mtab = (const LAS float*)(lds + TAB_OFF);
        { MapSched<MapU1> S{{W(char, WS_Q), W(char, WS_K)}, 512, G, bx}; FU1 f{W(bf16_t, WS_SQ), W(float, WS_DENP), W(float, WS_TA), W(float, WS_TPM), mtab, 0.f}; GEMM(7, 1, 2048, 2048, 256, S, f); }
        { MapSched<MapU2> S{{W(char, WS_VWT), W(char, WS_KT)}, 512, G, bx}; FU2 f{W(bf16_t, WS_DCL)}; GEMM(8, 0, 65536, 65536, 256, S, f); }
        { MapSched<MapY> S{{W(char, WS_UP), W(char, WS_T16O)}, 256, G, bx}; FY f{W(bf16_t, WS_UP), W(bf16_t, WS_YSP), A->in[20]}; GEMM(9, 0, 24576, 768, 384, S, f); } }
    SEAM(6);
    if (IN(7)) { PHASE_ARGS; phase_state(lds); __syncthreads();
        { RegSched S; S.init(W(char, WS_YSP), 1024, W(char, WS_WGLU), 1024, 128, 2, G, bx); FG5 f{W(bf16_t, WS_YSP), W(bf16_t, WS_YS), A->in[22]}; GEMM(10, 0, 1024, 1024, 512, S, f); } }
    SEAM(7);
    if (IN(8)) { PHASE_ARGS;
        { MapSched<MapU4> S{{W(char, WS_SQ), W(char, WS_VC)}, 512, G, bx}; FU4 f{W(float, WS_RDN), W(bf16_t, WS_SIGO), W(bf16_t, WS_XCM), A->in[10], A->in[11], W(bf16_t, WS_OUTM)}; GEMM(11, 2, 4096, 1024, 512, S, f); }
        { RegSched S; S.init(W(char, WS_YS), 1024, W(char, WS_WUPS), 1024, 128, 8, G, bx); FG6 f{(const bf16_t*)A->out, W(bf16_t, WS_TMP)}; GEMM(12, 0, 1024, 1024, 512, S, f); } }
    SEAM(8);
    if (IN(9)) { PHASE_ARGS; RegSched S; S.init(W(char, WS_OUTM), 2048, W(char, WS_WUPM), 2048, 128, 8, G, bx); FG4 f{(const bf16_t*)A->out, W(bf16_t, WS_TMP), W(bf16_t, WS_MERGED)}; GEMM(13, 0, 2048, 2048, 1024, S, f); }
    SEAM(9);
    if (IN(10)) { PHASE_ARGS; RegSched S; S.init(W(char, WS_MERGED), 4096, W(char, WS_WOUT), 4096, 128, 8, G, bx); FG7 f{A->in[0], A->out, W(bf16_t, WS_X1B), W(float, WS_SSQ2)}; GEMM(14, 1, 4096, 4096, 2048, S, f); }
    SEAM(10);
    if (IN(11)) { PHASE_ARGS; RegSched S; S.init(W(char, WS_X1B), 4096, W(char, WS_WGU), 4096, 128, 44, G, bx); FG8 f{W(float, WS_SSQ2), W(bf16_t, WS_HB)}; GEMM(15, 3, 4096, 4096, 2048, S, f); }
    SEAM(11);
    if (IN(12)) { PHASE_ARGS; RegSched S; S.init(W(char, WS_HB), 11264, W(char, WS_WD), 11264, 128, 8, G, bx); FG9 f{A->out, W(float, WS_SSQ3)}; GEMM(16, 1, 11264, 11264, 5632, S, f); }
    SEAM(12);
    if (IN(13)) phase_final(lds);
#undef IN
#undef SEAM
#undef W
}

extern "C" void kernel_launch(void* const* d_in, const int* in_sizes, int n_in, void* d_out, int out_size, void* d_ws, size_t ws_size, hipStream_t stream) {
    static int grid = 0;
    if (grid == 0) {
        if (n_in != 31 || in_sizes[0] != M * DM || out_size != M * DM || ws_size < WS_END) { fprintf(stderr, "kernel_launch: unexpected shapes (n_in %d, in0 %d, out %d, ws %zu); nothing launched\n", n_in, n_in > 0 ? in_sizes[0] : -1, out_size, ws_size); grid = -1; return; }
        int dev = 0, cus = 0, per_cu = 0;
        if (hipGetDevice(&dev) != hipSuccess || hipDeviceGetAttribute(&cus, hipDeviceAttributeMultiprocessorCount, dev) != hipSuccess) { grid = -1; return; }
        if (hipFuncSetAttribute((const void*)fwd_kernel, hipFuncAttributeMaxDynamicSharedMemorySize, LDS_BYTES) != hipSuccess) { fprintf(stderr, "kernel_launch: hipFuncSetAttribute failed\n"); grid = -1; return; }
        if (hipOccupancyMaxActiveBlocksPerMultiprocessor(&per_cu, (const void*)fwd_kernel, NTHR, LDS_BYTES) != hipSuccess || per_cu < 1) fprintf(stderr, "kernel_launch: occupancy query reports %d\n", per_cu);
        (void)hipGetLastError();
        grid = cus;
    }
    if (grid < 0) return;
    if (hipMemsetAsync((char*)d_ws + WS_CTL, 0, CTL_ZERO_BYTES, stream) != hipSuccess) return;
    Args a{};
    for (int i = 0; i < 31; ++i) a.in[i] = (const float*)d_in[i];
    a.out = (float*)d_out; a.ws = (unsigned char*)d_ws;
    if (MK_N_LAUNCHES == 1) { a.ph_lo = 0; a.ph_hi = NPH; hipLaunchKernelGGL(fwd_kernel, dim3(grid), dim3(NTHR), LDS_BYTES, stream, a); }
    else for (int p = 0; p < NPH; ++p) { a.ph_lo = p; a.ph_hi = p + 1; hipLaunchKernelGGL(fwd_kernel, dim3(grid), dim3(NTHR), LDS_BYTES, stream, a); }
}
```

```cpp
#include <hip/hip_runtime.h>
#include <cstdio>
#include <cstdint>

#define LAS __attribute__((address_space(3)))
#define GAS __attribute__((address_space(1)))
typedef unsigned short bf16_t;
typedef short bf16x8 __attribute__((ext_vector_type(8)));
typedef float f32x4 __attribute__((ext_vector_type(4)));
typedef unsigned u32x4 __attribute__((ext_vector_type(4)));
typedef GAS unsigned gu32;

constexpr int BATCH = 4, SEQ = 8192, DM = 2048, M = BATCH * SEQ;
constexpr int MW = 1024, NH = 4, DH = 256, SW = 512, NG = 32, SP = 64;
constexpr int INC = 6656, FF = 5632;
constexpr int LC = 256, NCH = SEQ / LC;
constexpr int NJ = M / 16;
constexpr float EPS = 1e-6f;
constexpr int KTLD = M + 2048;
constexpr int NWAVES = 8, NTHR = 512;

constexpr size_t MiB = 1u << 20, KiB = 1u << 10;
constexpr size_t WS_CTL = 0, CTL_ZERO_BYTES = 64 * KiB;
constexpr size_t WS_RSTD1 = 1 * MiB, WS_SSQ2 = 1 * MiB + 128 * KiB, WS_SSQ3 = 1 * MiB + 256 * KiB;
constexpr size_t WS_TA = 1 * MiB + 512 * KiB, WS_TB = 2 * MiB, WS_TPM = 2 * MiB + 512 * KiB, WS_RDN = 3 * MiB, WS_CS = 3 * MiB + 512 * KiB;
constexpr size_t WS_GRAW = 4 * MiB, WS_DENP = 6 * MiB, WS_NLP = 8 * MiB;
constexpr size_t WS_WIN = 10 * MiB, WS_WGU = 36 * MiB, WS_WD = 80 * MiB, WS_WOUT = 102 * MiB, WS_WUPM = 110 * MiB, WS_WUPS = 114 * MiB, WS_WGLU = 116 * MiB;
constexpr size_t WS_WQ = 116 * MiB + 512 * KiB, WS_WK = 117 * MiB, WS_WV = 117 * MiB + 512 * KiB, WS_WG = 118 * MiB, WS_EMAT = 119 * MiB, WS_T16O = 123 * MiB;
constexpr size_t WS_XB = 130 * MiB, WS_VC = 130 * MiB, WS_MERGED = 130 * MiB;
constexpr size_t WS_SIGO = 258 * MiB, WS_UP = 322 * MiB, WS_XCM = 370 * MiB, WS_E = 498 * MiB, WS_Q = 530 * MiB, WS_K = 594 * MiB, WS_KT = 658 * MiB, WS_VWT = 726 * MiB;
constexpr size_t WS_SQ = 794 * MiB, WS_DCL = 922 * MiB, WS_YSP = 986 * MiB, WS_YS = 594 * MiB, WS_TMP = 658 * MiB, WS_OUTM = 922 * MiB, WS_X1B = 258 * MiB, WS_HB = 386 * MiB;
constexpr size_t WS_END = 1018 * MiB;
static_assert(WS_KT + (size_t)1024 * (M + 2048) * 2 <= WS_VWT && WS_VWT + (size_t)1024 * (M + 2048) * 2 <= WS_SQ && WS_SQ + 128 * MiB <= WS_DCL && WS_DCL + 64 * MiB <= WS_YSP && WS_YSP + 32 * MiB <= WS_END, "d_ws map");

__device__ __forceinline__ unsigned cvt_pk_bf16(float lo, float hi) { unsigned r; asm volatile("v_cvt_pk_bf16_f32 %0, %1, %2" : "=v"(r) : "v"(lo), "v"(hi)); return r; }
__device__ __forceinline__ float bf2f(unsigned short b) { return __uint_as_float((unsigned)b << 16); }
__device__ __forceinline__ unsigned short f2bf(float f) { return (unsigned short)(cvt_pk_bf16(f, 0.f) & 0xffffu); }
__device__ __forceinline__ float bfround(float f) { return __uint_as_float(cvt_pk_bf16(f, 0.f) << 16); }
__device__ __forceinline__ void st8bf(bf16_t* p, const float (&v)[8]) {
    u32x4 w; w.x = cvt_pk_bf16(v[0], v[1]); w.y = cvt_pk_bf16(v[2], v[3]); w.z = cvt_pk_bf16(v[4], v[5]); w.w = cvt_pk_bf16(v[6], v[7]); *(u32x4*)p = w; }
__device__ __forceinline__ void ld8bf(const bf16_t* p, float (&v)[8]) {
    const u32x4 w = *(const u32x4*)p;
    v[0] = __uint_as_float(w.x << 16); v[1] = __uint_as_float(w.x & 0xffff0000u); v[2] = __uint_as_float(w.y << 16); v[3] = __uint_as_float(w.y & 0xffff0000u);
    v[4] = __uint_as_float(w.z << 16); v[5] = __uint_as_float(w.z & 0xffff0000u); v[6] = __uint_as_float(w.w << 16); v[7] = __uint_as_float(w.w & 0xffff0000u); }
__device__ __forceinline__ void st8f(float* p, const float (&v)[8]) { *(f32x4*)p = (f32x4){v[0], v[1], v[2], v[3]}; *(f32x4*)(p + 4) = (f32x4){v[4], v[5], v[6], v[7]}; }
__device__ __forceinline__ void ld8f(const float* p, float (&v)[8]) { const f32x4 a = *(const f32x4*)p, b = *(const f32x4*)(p + 4); v[0] = a[0]; v[1] = a[1]; v[2] = a[2]; v[3] = a[3]; v[4] = b[0]; v[5] = b[1]; v[6] = b[2]; v[7] = b[3]; }
__device__ __forceinline__ float sigmoidf_(float x) { return __builtin_amdgcn_rcpf(1.f + __expf(-x)); }
__device__ __forceinline__ float ldu(const float* p) { return __uint_as_float(__hip_atomic_load((const unsigned*)p, __ATOMIC_RELAXED, __HIP_MEMORY_SCOPE_AGENT)); }
__device__ __forceinline__ float wave_sum(float v) {
#pragma unroll
    for (int o = 1; o < 64; o <<= 1) v += __shfl_xor(v, o);
    return v; }

namespace pg8 {
constexpr int BM = 256, BK = 64, HALF = 128, HTB = HALF * BK * 2, STAGE_BYTES = 8 * HTB;
__host__ __device__ __forceinline__ int lds_byte(int r, int c) { const int st = (r >> 4) * 2 + (c >> 5), rr = r & 15, cc = c & 31, ob = rr * 64 + cc * 2; return st * 1024 + (ob ^ (((ob >> 9) & 1) << 5)); }
__host__ __device__ __forceinline__ void stage_rc(int b, int& R, int& C) { const int st = b / 1024, sb = b % 1024, swz = sb ^ (((sb >> 9) & 1) << 5); R = (st >> 1) * 16 + swz / 64; C = (st & 1) * 32 + (swz % 64) / 2; }
__host__ __device__ __forceinline__ int perm32(int rho) { const int n = rho >> 4, i = rho & 15; return 8 * (i >> 2) + 4 * n + (i & 3); }
}
struct Unit { int pm, pn, z; const char* a; const char* b; };

#define EPI_GETV(v, A0, A1) do { v[0] = A0[0]; v[1] = A0[1]; v[2] = A0[2]; v[3] = A0[3]; v[4] = A1[0]; v[5] = A1[1]; v[6] = A1[2]; v[7] = A1[3]; } while (0)
template <int MODE, class F>
__device__ __forceinline__ void run_epilogue(f32x4 (&acc)[2][2][4][2], const Unit& u, F& f, int wr, int wc, int fr, int fq, LAS float* xch) {
    asm volatile("" : "+v"(fr), "+v"(fq));
    asm volatile("" : "+s"(wr), "+s"(wc));
    const int clb = wc * 32 + fq * 8;
    f.begin(u, clb);
    if constexpr (MODE == 0 || MODE == 1) {
#pragma unroll
        for (int ai = 0; ai < 2; ++ai)
#pragma unroll
          for (int mb = 0; mb < 4; mb += F::MB) { typename F::Pre pre[4][2];
#pragma unroll
            for (int m = mb; m < mb + F::MB; ++m)
#pragma unroll
                for (int bj = 0; bj < 2; ++bj) f.load(u, ai * 128 + wr * 64 + m * 16 + fr, bj * 128 + clb, bj, pre[m][bj]);
#pragma unroll
            for (int m = mb; m < mb + F::MB; ++m) { const int rl = ai * 128 + wr * 64 + m * 16 + fr; float part = 0.f;
#pragma unroll
                for (int bj = 0; bj < 2; ++bj) { float v[8]; EPI_GETV(v, acc[ai][bj][m][0], acc[ai][bj][m][1]);
                    if constexpr (MODE == 0) f.store(u, rl, bj * 128 + clb, bj, v, pre[m][bj]); else part += f.store(u, rl, bj * 128 + clb, bj, v, pre[m][bj]); }
                if constexpr (MODE == 1) { part += __shfl_xor(part, 16); part += __shfl_xor(part, 32); if (fq == 0) f.rowpart(u, rl, wc, part); } } }
    } else if constexpr (MODE == 2) {
#pragma unroll
        for (int ai = 0; ai < 2; ++ai) { typename F::Pre1 pre[4];
#pragma unroll
            for (int m = 0; m < 4; ++m) f.load1(u, ai * 128 + wr * 64 + m * 16 + fr, pre[m]);
#pragma unroll
            for (int m = 0; m < 4; ++m) { const int rl = ai * 128 + wr * 64 + m * 16 + fr; float part = 0.f;
#pragma unroll
                for (int bj = 0; bj < 2; ++bj) { float v[8]; EPI_GETV(v, acc[ai][bj][m][0], acc[ai][bj][m][1]);
                    part += f.part(u, rl, bj * 128 + clb, bj, v, pre[m]);
                    acc[ai][bj][m][0] = (f32x4){v[0], v[1], v[2], v[3]}; acc[ai][bj][m][1] = (f32x4){v[4], v[5], v[6], v[7]}; }
                part += __shfl_xor(part, 16); part += __shfl_xor(part, 32); if (fq == 0) xch[rl * 4 + wc] = part; } }
        asm volatile("s_waitcnt lgkmcnt(0)" ::: "memory"); __builtin_amdgcn_s_barrier(); asm volatile("" ::: "memory");
#pragma unroll
        for (int ai = 0; ai < 2; ++ai)
#pragma unroll
          for (int mb = 0; mb < 4; mb += F::MB) { typename F::Pre2 pre[4][2];
#pragma unroll
            for (int m = mb; m < mb + F::MB; ++m)
#pragma unroll
                for (int bj = 0; bj < 2; ++bj) f.load2(u, ai * 128 + wr * 64 + m * 16 + fr, bj * 128 + clb, bj, pre[m][bj]);
#pragma unroll
            for (int m = mb; m < mb + F::MB; ++m) { const int rl = ai * 128 + wr * 64 + m * 16 + fr;
                const f32x4 t4 = *(const LAS f32x4*)(xch + rl * 4); const float tot = (t4[0] + t4[1]) + (t4[2] + t4[3]);
#pragma unroll
                for (int bj = 0; bj < 2; ++bj) { float v[8]; EPI_GETV(v, acc[ai][bj][m][0], acc[ai][bj][m][1]);
                    f.store2(u, rl, bj * 128 + clb, bj, v, tot, pre[m][bj]); } } }
    } else {
#pragma unroll
        for (int ai = 0; ai < 2; ++ai) { typename F::Pre pre[4];
#pragma unroll
            for (int m = 0; m < 4; ++m) f.load(u, ai * 128 + wr * 64 + m * 16 + fr, clb, 0, pre[m]);
#pragma unroll
            for (int m = 0; m < 4; ++m) { const int rl = ai * 128 + wr * 64 + m * 16 + fr; float vg[8], vu[8];
                EPI_GETV(vg, acc[ai][0][m][0], acc[ai][0][m][1]); EPI_GETV(vu, acc[ai][1][m][0], acc[ai][1][m][1]);
                f.store_pair(u, rl, clb, vg, vu, pre[m]); } }
    }
}

template <int MODE, class F, class S, bool EPI2 = false>
__device__ __forceinline__ void gemm_phase(LAS unsigned char* lds, const int lda, const int ldb, const int K, const S& sched, F& fun) {
    using namespace pg8;
    int tid_ = threadIdx.x; asm volatile("" : "+v"(tid_));
    const int tid = tid_, wid = __builtin_amdgcn_readfirstlane(tid >> 6), lane = tid & 63, wr = wid >> 2, wc = wid & 3, fr = lane & 15, fq = lane >> 4;
    const int nt = K / BK;
    LAS float* xch = (LAS float*)(lds + STAGE_BYTES);
    unsigned voffA[2], voffB[2];
#pragma unroll
    for (int i = 0; i < 2; ++i) { int R, C; stage_rc(tid * 16 + i * 8192, R, C); const int Rb = (R & ~31) + perm32(R & 31);
        voffA[i] = (unsigned)(R * lda + C * 2); voffB[i] = (unsigned)(Rb * ldb + C * 2); }
    const size_t kstep = (size_t)(BK * 2);
    const size_t hstepA = (size_t)HALF * lda, hstepB = (size_t)HALF * ldb;
    const unsigned ldsw = (unsigned)wid * 1024u;
    const int aoff = lds_byte(wr * 64 + fr, fq * 8), boff = lds_byte(wc * 32 + fr, fq * 8);
#define PG8_SA(b, h) (((b) * 2 + (h)) * HTB)
#define PG8_SB(b, h) ((4 + (b) * 2 + (h)) * HTB)
#define PG8_STAGE(bufoff, gbase, voff) do { _Pragma("unroll") for (int _i = 0; _i < 2; ++_i) \
        __builtin_amdgcn_global_load_lds((const unsigned*)((const char*)(gbase) + (voff)[_i]), (LAS unsigned*)(lds + (bufoff) + ldsw + _i * 8192), 16, 0, 0); } while (0)
#define PG8_LDA(dst, b, h) do { _Pragma("unroll") for (int m = 0; m < 4; ++m) _Pragma("unroll") for (int k = 0; k < 2; ++k) dst[m][k] = *(const LAS bf16x8*)(lds + PG8_SA(b, h) + aoff + m * 2048 + k * 1024); } while (0)
#define PG8_LDB(dst, b, h) do { _Pragma("unroll") for (int n = 0; n < 2; ++n) _Pragma("unroll") for (int k = 0; k < 2; ++k) dst[n][k] = *(const LAS bf16x8*)(lds + PG8_SB(b, h) + boff + n * 2048 + k * 1024); } while (0)
#define PG8_MMA(ai, bj, At, Bt) do { __builtin_amdgcn_s_setprio(1); _Pragma("unroll") for (int m = 0; m < 4; ++m) _Pragma("unroll") for (int n = 0; n < 2; ++n) _Pragma("unroll") for (int k = 0; k < 2; ++k) \
        acc[ai][bj][m][n] = __builtin_amdgcn_mfma_f32_16x16x32_bf16(Bt[n][k], At[m][k], acc[ai][bj][m][n], 0, 0, 0); __builtin_amdgcn_s_setprio(0); } while (0)
#define PG8_WAIT_V(n) asm volatile("s_waitcnt vmcnt(" #n ")" ::: "memory")
#define PG8_WAIT_L(n) asm volatile("s_waitcnt lgkmcnt(" #n ")" ::: "memory")
#define PG8_BAR __builtin_amdgcn_s_barrier()
#define PG8_SCHED __builtin_amdgcn_sched_barrier(0)
    Unit cur, nxt; int ui = 0;
    if (!sched.next(0, cur)) return;
    f32x4 acc[2][2][4][2];
#pragma unroll
    for (int a = 0; a < 2; ++a)
#pragma unroll
        for (int b = 0; b < 2; ++b)
#pragma unroll
            for (int m = 0; m < 4; ++m)
#pragma unroll
                for (int n = 0; n < 2; ++n) acc[a][b][m][n] = (f32x4){0.f, 0.f, 0.f, 0.f};
    bf16x8 At[4][2], B0[2][2], B1[2][2];
    const char* cA = cur.a; const char* cB = cur.b;
    PG8_STAGE(PG8_SB(0, 0), cB, voffB); PG8_STAGE(PG8_SB(0, 1), cB + hstepB, voffB); PG8_STAGE(PG8_SA(0, 0), cA, voffA); PG8_STAGE(PG8_SA(0, 1), cA + hstepA, voffA);
    if (wr == 1) PG8_BAR;
    PG8_WAIT_V(2); PG8_BAR;
    PG8_STAGE(PG8_SB(1, 0), cB + kstep, voffB); PG8_STAGE(PG8_SA(1, 0), cA + kstep, voffA); PG8_STAGE(PG8_SB(1, 1), cB + hstepB + kstep, voffB);
    PG8_WAIT_V(6); PG8_BAR;
    for (;;) {
        const bool has_next = sched.next(ui + 1, nxt);
        const char* nA = has_next ? nxt.a : cA; const char* nB = has_next ? nxt.b : cB;
        for (int t = 0; t < nt; t += 2) {
            const bool last = (t == nt - 2);
            const char* a1 = cA + (size_t)(t + 1) * kstep;
            const char* a2 = last ? nA : cA + (size_t)(t + 2) * kstep; const char* b2 = last ? nB : cB + (size_t)(t + 2) * kstep;
            const char* a3 = a2 + kstep; const char* b3 = b2 + kstep;
            PG8_LDB(B0, 0, 0); PG8_LDB(B1, 0, 1); PG8_SCHED; PG8_LDA(At, 0, 0); PG8_STAGE(PG8_SA(1, 1), a1 + hstepA, voffA);
            PG8_WAIT_V(8); PG8_WAIT_L(0); PG8_BAR; PG8_MMA(0, 0, At, B0); PG8_MMA(0, 1, At, B1); PG8_BAR; PG8_SCHED;
            PG8_LDA(At, 0, 1); PG8_STAGE(PG8_SB(0, 0), b2, voffB); PG8_STAGE(PG8_SB(0, 1), b2 + hstepB, voffB); PG8_STAGE(PG8_SA(0, 0), a2, voffA);
            PG8_WAIT_V(8); PG8_WAIT_L(0); PG8_BAR; PG8_MMA(1, 0, At, B0); PG8_MMA(1, 1, At, B1); PG8_BAR; PG8_SCHED;
            PG8_LDB(B0, 1, 0); PG8_LDB(B1, 1, 1); PG8_SCHED; PG8_LDA(At, 1, 0); PG8_STAGE(PG8_SA(0, 1), a2 + hstepA, voffA);
            PG8_WAIT_V(8); PG8_WAIT_L(0); PG8_BAR; PG8_MMA(0, 0, At, B0); PG8_MMA(0, 1, At, B1); PG8_BAR; PG8_SCHED;
            PG8_LDA(At, 1, 1); PG8_STAGE(PG8_SB(1, 0), b3, voffB); PG8_STAGE(PG8_SB(1, 1), b3 + hstepB, voffB); PG8_STAGE(PG8_SA(1, 0), a3, voffA);
            PG8_WAIT_V(8); PG8_WAIT_L(0); PG8_BAR; PG8_MMA(1, 0, At, B0); PG8_MMA(1, 1, At, B1); PG8_BAR; PG8_SCHED;
        }
        if (wr == 0) PG8_BAR;
        run_epilogue<MODE, F>(acc, cur, fun, wr, wc, fr, fq, xch);
        if constexpr (EPI2) { asm volatile("s_waitcnt vmcnt(0)" ::: "memory"); run_epilogue<MODE, F>(acc, cur, fun, wr, wc, fr, fq, xch); }
        if (!has_next) break;
#pragma unroll
        for (int a = 0; a < 2; ++a)
#pragma unroll
            for (int b = 0; b < 2; ++b)
#pragma unroll
                for (int m = 0; m < 4; ++m)
#pragma unroll
                    for (int n = 0; n < 2; ++n) acc[a][b][m][n] = (f32x4){0.f, 0.f, 0.f, 0.f};
        cur = nxt; cA = nA; cB = nB; ++ui;
        if (wr == 1) PG8_BAR;
    }
    PG8_WAIT_V(0);
    PG8_BAR;
#undef PG8_SA
#undef PG8_SB
#undef PG8_STAGE
#undef PG8_LDA
#undef PG8_LDB
#undef PG8_MMA
#undef PG8_WAIT_V
#undef PG8_WAIT_L
#undef PG8_BAR
#undef PG8_SCHED
}

template <int MODE, class F, class S>
__device__ __forceinline__ void gemm_naive(LAS unsigned char* lds, const int lda, const int ldb, const int K, const S& sched, F& fun) {
    LAS float* xch = (LAS float*)(lds + pg8::STAGE_BYTES);
    const int tid = threadIdx.x;
    Unit u;
    for (int ui = 0; sched.next(ui, u); ++ui) {
        for (int pass = 0; pass < (MODE == 2 ? 2 : 1); ++pass) {
            for (int item = tid; item < 1024; item += NTHR) {
                const int rl = item >> 2, wc = item & 3; float part = 0.f;
                const bf16_t* ar = (const bf16_t*)(u.a + (size_t)rl * lda);
                float tot = 0.f; if (MODE == 2 && pass == 1) tot = (xch[rl * 4] + xch[rl * 4 + 1]) + (xch[rl * 4 + 2] + xch[rl * 4 + 3]);
                for (int fq = 0; fq < 4; ++fq) { const int clb = wc * 32 + fq * 8; fun.begin(u, clb);
                    for (int bj = 0; bj < (MODE == 3 ? 1 : 2); ++bj) { const int cl = bj * 128 + clb;
                        float v[8], v2[8];
                        for (int i = 0; i < 8; ++i) { const bf16_t* br = (const bf16_t*)(u.b + (size_t)(cl + i) * ldb); float s = 0.f;
                            for (int k = 0; k < K; ++k) s += bf2f(ar[k]) * bf2f(br[k]); v[i] = s; }
                        if (MODE == 3) { for (int i = 0; i < 8; ++i) { const bf16_t* br = (const bf16_t*)(u.b + (size_t)(128 + cl + i) * ldb); float s = 0.f;
                            for (int k = 0; k < K; ++k) s += bf2f(ar[k]) * bf2f(br[k]); v2[i] = s; } }
                        if constexpr (MODE == 0) { typename F::Pre pre; fun.load(u, rl, cl, bj, pre); fun.store(u, rl, cl, bj, v, pre); }
                        else if constexpr (MODE == 1) { typename F::Pre pre; fun.load(u, rl, cl, bj, pre); part += fun.store(u, rl, cl, bj, v, pre); }
                        else if constexpr (MODE == 2) { typename F::Pre1 p1; fun.load1(u, rl, p1); part += fun.part(u, rl, cl, bj, v, p1);
                            if (pass == 1) { typename F::Pre2 p2; fun.load2(u, rl, cl, bj, p2); fun.store2(u, rl, cl, bj, v, tot, p2); } }
                        else { typename F::Pre pre; fun.load(u, rl, cl, 0, pre); fun.store_pair(u, rl, cl, v, v2, pre); }
                    } }
                if constexpr (MODE == 1) fun.rowpart(u, rl, wc, part);
                if (MODE == 2 && pass == 0) xch[rl * 4 + wc] = part;
            }
            __syncthreads();
        }
    }
}

struct RegSched {
    const char* A; const char* B; size_t tA, tB; int nM, nN, nwg, G, c;
    __device__ __forceinline__ void init(const void* A_, int lda, const void* B_, int ldb, int nM_, int nN_, int G_, int c_) {
        A = (const char*)A_; B = (const char*)B_; tA = (size_t)256 * lda; tB = (size_t)256 * ldb; nM = nM_; nN = nN_; nwg = nM_ * nN_; G = G_; c = c_; }
    __device__ __forceinline__ bool next(int i, Unit& u) const {
        const long L = (long)i * G + c; if (L >= nwg) return false;
        int wgid = (int)L; { const int q = nwg / 8, r = nwg % 8, xcd = wgid % 8, off = wgid / 8; wgid = (xcd < r ? xcd * (q + 1) : r * (q + 1) + (xcd - r) * q) + off; }
        const int nig = 8 * nN, gid = wgid / nig, fm = gid * 8, gsz = (nM - fm) < 8 ? (nM - fm) : 8;
        u.pm = fm + ((wgid % nig) % gsz); u.pn = (wgid % nig) / gsz; u.z = 0;
        u.a = A + (size_t)u.pm * tA; u.b = B + (size_t)u.pn * tB; return true; }
};
template <class Map> struct MapSched {
    Map map; int nunits, G, c;
    __device__ __forceinline__ bool next(int i, Unit& u) const { const int L = i * G + c; if (L >= nunits) return false; map(L, u); return true; }
};
struct MapX { const char* up; const char* emat;
    __device__ __forceinline__ void operator()(int L, Unit& u) const { const int g = L >> 3, pm = L & 7; u.pm = pm; u.pn = 0; u.z = g;
        u.a = up + (size_t)g * 768 + (size_t)pm * 256 * 24576; u.b = emat + (size_t)g * 131072; } };
struct MapY { const char* up; const char* t16o;
    __device__ __forceinline__ void operator()(int L, Unit& u) const { const int g = L >> 3, pm = L & 7; u.pm = pm; u.pn = 0; u.z = g;
        u.a = up + (size_t)g * 768 + (size_t)pm * 256 * 24576; u.b = t16o + (size_t)g * 196608; } };
struct MapProjN { const char* xcm; const char* w; int acol;
    __device__ __forceinline__ void operator()(int L, Unit& u) const { const int x = L & 7, r = L >> 3, pm = (r >> 2) * 8 + x, h = r & 3; u.pm = pm; u.pn = 0; u.z = h;
        u.a = xcm + (size_t)pm * 256 * 4096 + acol + h * 512; u.b = w + (size_t)h * 131072; } };
struct MapProjT { const char* xcm; const char* w; int acol;
    __device__ __forceinline__ void operator()(int L, Unit& u) const { const int x = L & 7, r = L >> 3, pn = (r >> 2) * 8 + x, h = r & 3; u.pm = 0; u.pn = pn; u.z = h;
        u.a = w + (size_t)h * 131072; u.b = xcm + (size_t)pn * 256 * 4096 + acol + h * 512; } };
struct MapU1 { const char* q; const char* k;
    __device__ __forceinline__ void operator()(int L, Unit& u) const { const int z = L, c = z & 31, bh = z >> 5, h = bh & 3, b = bh >> 2; u.pm = 0; u.pn = 0; u.z = z;
        const size_t off = (size_t)(b * SEQ + c * LC) * 2048 + h * 512; u.a = q + off; u.b = k + off; } };
struct MapU2 { const char* vwt; const char* kt;
    __device__ __forceinline__ void operator()(int L, Unit& u) const { const int z = L, c = z & 31, bh = z >> 5, h = bh & 3, b = bh >> 2; u.pm = 0; u.pn = 0; u.z = z;
        const size_t off = (size_t)(h * 256) * (KTLD * 2) + (size_t)(b * SEQ + c * LC) * 2; u.a = vwt + off; u.b = kt + off; } };
struct MapU4 { const char* sq; const char* vc;
    __device__ __forceinline__ void operator()(int L, Unit& u) const { const int z = L, c = z & 31, bh = z >> 5, h = bh & 3, b = bh >> 2; u.pm = 0; u.pn = 0; u.z = z;
        u.a = sq + ((size_t)(b * SEQ + c * LC) * 4 + h) * 1024; u.b = vc + (size_t)z * 262144; } };

struct NoPre {};
__device__ __forceinline__ void unpack8(const u32x4& w, float (&v)[8]) {
    v[0] = __uint_as_float(w.x << 16); v[1] = __uint_as_float(w.x & 0xffff0000u); v[2] = __uint_as_float(w.y << 16); v[3] = __uint_as_float(w.y & 0xffff0000u);
    v[4] = __uint_as_float(w.z << 16); v[5] = __uint_as_float(w.z & 0xffff0000u); v[6] = __uint_as_float(w.w << 16); v[7] = __uint_as_float(w.w & 0xffff0000u); }
struct FG1 { static constexpr int MB = 4; const float* rstd; bf16_t* xcm; bf16_t* sigo; bf16_t* up; bf16_t* gate; const float* bgate; float bg[2][8];
    struct Pre { float r; };
    __device__ __forceinline__ void begin(const Unit& u, int clb) { const int col = u.pn * 256 + clb;
        if (col >= 2560) { ld8f(bgate + (col - 2560), bg[0]); ld8f(bgate + (col - 2560) + 128, bg[1]); } }
    __device__ __forceinline__ void load(const Unit& u, int rl, int cl, int bj, Pre& p) const { p.r = rstd[u.pm * 256 + rl]; }
    __device__ __forceinline__ void store(const Unit& u, int rl, int cl, int bj, float (&v)[8], const Pre& p) const {
        const int row = u.pm * 256 + rl, col = u.pn * 256 + cl; const float r = p.r;
#pragma unroll
        for (int i = 0; i < 8; ++i) v[i] *= r;
        if (col < 1024) st8bf(xcm + (size_t)row * 2048 + 1024 + col, v);
        else if (col < 2048) {
#pragma unroll
            for (int i = 0; i < 8; ++i) v[i] = sigmoidf_(v[i]);
            st8bf(sigo + (size_t)row * 1024 + (col - 1024), v); }
        else if (col < 2560) { const int ch = col - 2048, g = ch >> 4, cp = ch & 15, J = row >> 4, s = row & 15; st8bf(up + ((size_t)J * 32 + g) * 384 + s * 16 + cp, v); }
        else { const int gc = col - 2560;
#pragma unroll
            for (int i = 0; i < 8; ++i) v[i] = sigmoidf_(v[i] + bg[bj][i]);
            st8bf(gate + (size_t)row * 4096 + gc, v); }
    } };
struct FGates { static constexpr int MB = 4; float* graw; typedef NoPre Pre;
    __device__ __forceinline__ void begin(const Unit&, int) {}
    __device__ __forceinline__ void load(const Unit&, int, int, int, Pre&) const {}
    __device__ __forceinline__ void store(const Unit& u, int rl, int cl, int bj, float (&v)[8], const Pre&) const { if (cl < 16) st8f(graw + (size_t)(u.pm * 256 + rl) * 16 + cl, v); } };
struct FX { static constexpr int MB = 4; float* e; typedef NoPre Pre;
    __device__ __forceinline__ void begin(const Unit&, int) {}
    __device__ __forceinline__ void load(const Unit&, int, int, int, Pre&) const {}
    __device__ __forceinline__ void store(const Unit& u, int rl, int cl, int bj, float (&v)[8], const Pre&) const { if (cl < 128) st8f(e + ((size_t)(u.pm * 256 + rl) * 32 + u.z) * 128 + cl, v); } };
struct FQ { static constexpr int MB = 4; bf16_t* q; bf16_t* sq; const float* tpm; const LAS float* tab; float mc;
    struct Pre { float pm; };
    __device__ __forceinline__ void begin(const Unit& u, int) { mc = tab[((u.pm >> 5) * 4 + u.z) * 32 + (u.pm & 31)]; }
    __device__ __forceinline__ void load(const Unit& u, int rl, int cl, int bj, Pre& p) const { p.pm = tpm[(size_t)u.z * M + u.pm * 256 + rl]; }
    __device__ __forceinline__ void store(const Unit& u, int rl, int cl, int bj, float (&v)[8], const Pre& p) const {
        const int row = u.pm * 256 + rl, h = u.z; st8bf(q + (size_t)row * 1024 + h * 256 + cl, v);
        const float w = __expf(mc - fmaxf(mc, p.pm));
#pragma unroll
        for (int i = 0; i < 8; ++i) v[i] *= w;
        st8bf(sq + ((size_t)row * 4 + h) * 512 + 256 + cl, v); } };
struct FK { static constexpr int MB = 4; bf16_t* k; typedef NoPre Pre;
    __device__ __forceinline__ void begin(const Unit&, int) {}
    __device__ __forceinline__ void load(const Unit&, int, int, int, Pre&) const {}
    __device__ __forceinline__ void store(const Unit& u, int rl, int cl, int bj, float (&v)[8], const Pre&) const { st8bf(k + (size_t)(u.pm * 256 + rl) * 1024 + u.z * 256 + cl, v); } };
struct FKT { static constexpr int MB = 4; bf16_t* kt; float* nlp; const float* ta; const LAS float* tab; float w[2][8]; typedef NoPre Pre;
    __device__ __forceinline__ void begin(const Unit& u, int clb) { const float amax = tab[512 + ((u.pn >> 5) * 4 + u.z) * 32 + (u.pn & 31)];
#pragma unroll
        for (int bj = 0; bj < 2; ++bj) { float a[8]; ld8f(ta + (size_t)u.z * M + u.pn * 256 + bj * 128 + clb, a);
#pragma unroll
            for (int i = 0; i < 8; ++i) w[bj][i] = __expf(a[i] - amax); } }
    __device__ __forceinline__ void load(const Unit&, int, int, int, Pre&) const {}
    __device__ __forceinline__ float store(const Unit& u, int rl, int cl, int bj, float (&v)[8], const Pre&) const {
        const int h = u.z, tok = u.pn * 256 + cl; st8bf(kt + (size_t)(h * 256 + rl) * KTLD + tok, v); float s = 0.f;
#pragma unroll
        for (int i = 0; i < 8; ++i) s += v[i] * w[bj][i];
        return s; }
    __device__ __forceinline__ void rowpart(const Unit& u, int rl, int wc, float part) const { const int zc = ((u.pn >> 5) * 4 + u.z) * 32 + (u.pn & 31); nlp[((size_t)zc * 256 + rl) * 4 + wc] = part; } };
struct FVT { static constexpr int MB = 4; bf16_t* vc; bf16_t* vwt; const float* ta; const LAS float* tab; float w[2][8]; typedef NoPre Pre;
    __device__ __forceinline__ void begin(const Unit& u, int clb) { const float amax = tab[512 + ((u.pn >> 5) * 4 + u.z) * 32 + (u.pn & 31)];
#pragma unroll
        for (int bj = 0; bj < 2; ++bj) { float a[8]; ld8f(ta + (size_t)u.z * M + u.pn * 256 + bj * 128 + clb, a);
#pragma unroll
            for (int i = 0; i < 8; ++i) w[bj][i] = __expf(a[i] - amax); } }
    __device__ __forceinline__ void load(const Unit&, int, int, int, Pre&) const {}
    __device__ __forceinline__ void store(const Unit& u, int rl, int cl, int bj, float (&v)[8], const Pre&) const {
        const int h = u.z, tok = u.pn * 256 + cl, zc = ((u.pn >> 5) * 4 + h) * 32 + (u.pn & 31);
        st8bf(vc + ((size_t)zc * 256 + rl) * 512 + cl, v);
#pragma unroll
        for (int i = 0; i < 8; ++i) v[i] *= w[bj][i];
        st8bf(vwt + (size_t)(h * 256 + rl) * KTLD + tok, v); } };
struct FU1 { static constexpr int MB = 1; bf16_t* sq; float* denp; const float* ta; const float* tpm; const LAS float* tab; float mc; float a[2][8];
    struct Pre { float pm; };
    __device__ __forceinline__ void begin(const Unit& u, int clb) { mc = tab[u.z]; const int c = u.z & 31, bh = u.z >> 5, h = bh & 3, b = bh >> 2;
        ld8f(ta + (size_t)h * M + b * SEQ + c * LC + clb, a[0]); ld8f(ta + (size_t)h * M + b * SEQ + c * LC + 128 + clb, a[1]); }
    __device__ __forceinline__ void load(const Unit& u, int rl, int cl, int bj, Pre& p) const { const int c = u.z & 31, bh = u.z >> 5, h = bh & 3, b = bh >> 2; p.pm = tpm[(size_t)h * M + b * SEQ + c * LC + rl]; }
    __device__ __forceinline__ float store(const Unit& u, int rl, int cl, int bj, float (&v)[8], const Pre& p) const {
        const int c = u.z & 31, bh = u.z >> 5, h = bh & 3, b = bh >> 2, row = b * SEQ + c * LC + rl;
        const float Mt = fmaxf(mc, p.pm); float s = 0.f;
#pragma unroll
        for (int i = 0; i < 8; ++i) { const float x = (cl + i <= rl) ? bfround(v[i] * __expf(a[bj][i] - Mt)) : 0.f; v[i] = x; s += x; }
        st8bf(sq + ((size_t)row * 4 + h) * 512 + cl, v); return s; }
    __device__ __forceinline__ void rowpart(const Unit& u, int rl, int wc, float part) const {
        const int c = u.z & 31, bh = u.z >> 5, h = bh & 3, b = bh >> 2, row = b * SEQ + c * LC + rl; denp[((size_t)h * M + row) * 4 + wc] = part; } };
struct FU2 { static constexpr int MB = 4; bf16_t* dcl; typedef NoPre Pre;
    __device__ __forceinline__ void begin(const Unit&, int) {}
    __device__ __forceinline__ void load(const Unit&, int, int, int, Pre&) const {}
    __device__ __forceinline__ void store(const Unit& u, int rl, int cl, int bj, float (&v)[8], const Pre&) const { st8bf(dcl + ((size_t)u.z * 256 + rl) * 256 + cl, v); } };
struct FY { static constexpr int MB = 4; const bf16_t* up; bf16_t* ysp; const float* dvec; float d[2][8];
    struct Pre { u32x4 uu; };
    __device__ __forceinline__ void begin(const Unit& u, int clb) { ld8f(dvec + u.z * 16 + (clb & 15), d[0]);
#pragma unroll
        for (int i = 0; i < 8; ++i) d[1][i] = d[0][i]; }
    __device__ __forceinline__ void load(const Unit& u, int rl, int cl, int bj, Pre& p) const { const int J = u.pm * 256 + rl; p.uu = *(const u32x4*)(up + ((size_t)J * 32 + u.z) * 384 + cl); }
    __device__ __forceinline__ void store(const Unit& u, int rl, int cl, int bj, float (&v)[8], const Pre& p) const {
        const int g = u.z, J = u.pm * 256 + rl, t = cl >> 4, c0 = cl & 15, tok = J * 16 + t, ch = g * 16 + c0; float uu[8]; unpack8(p.uu, uu);
#pragma unroll
        for (int i = 0; i < 8; ++i) { const float y = v[i] + d[0][i] * uu[i]; v[i] = y * sigmoidf_(1.5957691216f * (y + 0.044715f * y * y * y)); }
        st8bf(ysp + (size_t)tok * 512 + ch, v); } };
struct FG5 { static constexpr int MB = 4; const bf16_t* ysp; bf16_t* ys; const float* bglu; float bb[2][8];
    struct Pre { u32x4 y; };
    __device__ __forceinline__ void begin(const Unit& u, int clb) { ld8f(bglu + u.pn * 256 + clb, bb[0]); ld8f(bglu + u.pn * 256 + 128 + clb, bb[1]); }
    __device__ __forceinline__ void load(const Unit& u, int rl, int cl, int bj, Pre& p) const { p.y = *(const u32x4*)(ysp + (size_t)(u.pm * 256 + rl) * 512 + u.pn * 256 + cl); }
    __device__ __forceinline__ void store(const Unit& u, int rl, int cl, int bj, float (&v)[8], const Pre& p) const {
        const int row = u.pm * 256 + rl, col = u.pn * 256 + cl; float y[8]; unpack8(p.y, y);
#pragma unroll
        for (int i = 0; i < 8; ++i) v[i] = y[i] * sigmoidf_(v[i] + bb[bj][i]);
        st8bf(ys + (size_t)row * 512 + col, v); } };
struct FU4 { static constexpr int MB = 2; const float* rdn; const bf16_t* sigo; const bf16_t* xcm; const float* mhg; const float* skip; bf16_t* outm;
    struct Pre1 { float r; }; struct Pre2 { u32x4 so, xc; };
    __device__ __forceinline__ void begin(const Unit&, int) {}
    __device__ __forceinline__ void load1(const Unit& u, int rl, Pre1& p) const { const int c = u.z & 31, bh = u.z >> 5, h = bh & 3, b = bh >> 2; p.r = rdn[(size_t)h * M + b * SEQ + c * LC + rl]; }
    __device__ __forceinline__ float part(const Unit& u, int rl, int cl, int bj, float (&v)[8], const Pre1& p) const { float s = 0.f;
#pragma unroll
        for (int i = 0; i < 8; ++i) { v[i] *= p.r; s += v[i] * v[i]; }
        return s; }
    __device__ __forceinline__ void load2(const Unit& u, int rl, int cl, int bj, Pre2& p) const { const int c = u.z & 31, bh = u.z >> 5, h = bh & 3, b = bh >> 2, row = b * SEQ + c * LC + rl, col = h * 256 + cl;
        p.so = *(const u32x4*)(sigo + (size_t)row * 1024 + col); p.xc = *(const u32x4*)(xcm + (size_t)row * 2048 + col); }
    __device__ __forceinline__ void store2(const Unit& u, int rl, int cl, int bj, float (&v)[8], float tot, const Pre2& p) const {
        const int c = u.z & 31, bh = u.z >> 5, h = bh & 3, b = bh >> 2, row = b * SEQ + c * LC + rl, col = h * 256 + cl;
        const float rs = rsqrtf(tot * (1.f / 256.f) + EPS); float so[8], xc[8], g[8], sk[8]; unpack8(p.so, so); unpack8(p.xc, xc); ld8f(mhg + col, g); ld8f(skip + col, sk);
#pragma unroll
        for (int i = 0; i < 8; ++i) v[i] = so[i] * (v[i] * rs * g[i] + sk[i] * xc[i]);
        st8bf(outm + (size_t)row * 1024 + col, v); } };
struct FG6 { static constexpr int MB = 4; const bf16_t* gate; bf16_t* tmp;
    struct Pre { u32x4 g; };
    __device__ __forceinline__ void begin(const Unit&, int) {}
    __device__ __forceinline__ void load(const Unit& u, int rl, int cl, int bj, Pre& p) const { p.g = *(const u32x4*)(gate + (size_t)(u.pm * 256 + rl) * 4096 + 2048 + u.pn * 256 + cl); }
    __device__ __forceinline__ void store(const Unit& u, int rl, int cl, int bj, float (&v)[8], const Pre& p) const {
        const int row = u.pm * 256 + rl, col = u.pn * 256 + cl; float g[8]; unpack8(p.g, g);
#pragma unroll
        for (int i = 0; i < 8; ++i) v[i] *= g[i];
        st8bf(tmp + (size_t)row * 2048 + col, v); } };
struct FG4 { static constexpr int MB = 4; const bf16_t* gate; const bf16_t* tmp; bf16_t* merged;
    struct Pre { u32x4 g, t; };
    __device__ __forceinline__ void begin(const Unit&, int) {}
    __device__ __forceinline__ void load(const Unit& u, int rl, int cl, int bj, Pre& p) const { const int row = u.pm * 256 + rl, col = u.pn * 256 + cl;
        p.g = *(const u32x4*)(gate + (size_t)row * 4096 + col); p.t = *(const u32x4*)(tmp + (size_t)row * 2048 + col); }
    __device__ __forceinline__ void store(const Unit& u, int rl, int cl, int bj, float (&v)[8], const Pre& p) const {
        const int row = u.pm * 256 + rl, col = u.pn * 256 + cl; float g[8], t[8]; unpack8(p.g, g); unpack8(p.t, t);
#pragma unroll
        for (int i = 0; i < 8; ++i) v[i] = v[i] * g[i] + t[i];
        st8bf(merged + (size_t)row * 2048 + col, v); } };
struct FG7 { static constexpr int MB = 4; const float* x; bf16_t* x1b; float* ssq;
    struct Pre { f32x4 a, b; };
    __device__ __forceinline__ void begin(const Unit&, int) {}
    __device__ __forceinline__ void load(const Unit& u, int rl, int cl, int bj, Pre& p) const { const float* s = x + (size_t)(u.pm * 256 + rl) * 2048 + u.pn * 256 + cl; p.a = *(const f32x4*)s; p.b = *(const f32x4*)(s + 4); }
    __device__ __forceinline__ float store(const Unit& u, int rl, int cl, int bj, float (&v)[8], const Pre& p) const {
        const int row = u.pm * 256 + rl, col = u.pn * 256 + cl; float s = 0.f;
#pragma unroll
        for (int i = 0; i < 4; ++i) { v[i] += p.a[i]; v[4 + i] += p.b[i]; }
#pragma unroll
        for (int i = 0; i < 8; ++i) s += v[i] * v[i];
        st8bf(x1b + (size_t)row * 2048 + col, v); return s; }
    __device__ __forceinline__ void rowpart(const Unit& u, int rl, int wc, float part) const { atomicAdd(ssq + u.pm * 256 + rl, part); } };
struct FG8 { static constexpr int MB = 4; const float* ssq; bf16_t* hb;
    struct Pre { float s; };
    __device__ __forceinline__ void begin(const Unit&, int) {}
    __device__ __forceinline__ void load(const Unit& u, int rl, int cl, int bj, Pre& p) const { p.s = ssq[u.pm * 256 + rl]; }
    __device__ __forceinline__ void store_pair(const Unit& u, int rl, int cl, float (&vg)[8], float (&vu)[8], const Pre& p) const {
        const int row = u.pm * 256 + rl; const float r = rsqrtf(p.s * (1.f / 2048.f) + EPS);
#pragma unroll
        for (int i = 0; i < 8; ++i) { const float g = vg[i] * r; vg[i] = g * sigmoidf_(g) * (vu[i] * r); }
        st8bf(hb + (size_t)row * FF + u.pn * 128 + cl, vg); } };
struct FG9 { static constexpr int MB = 4; const bf16_t* x1b; float* out; float* ssq;
    struct Pre { u32x4 a; };
    __device__ __forceinline__ void begin(const Unit&, int) {}
    __device__ __forceinline__ void load(const Unit& u, int rl, int cl, int bj, Pre& p) const { p.a = *(const u32x4*)(x1b + (size_t)(u.pm * 256 + rl) * 2048 + u.pn * 256 + cl); }
    __device__ __forceinline__ float store(const Unit& u, int rl, int cl, int bj, float (&v)[8], const Pre& p) const {
        const int row = u.pm * 256 + rl, col = u.pn * 256 + cl; float s = 0.f, xx[8]; unpack8(p.a, xx);
#pragma unroll
        for (int i = 0; i < 8; ++i) { v[i] += xx[i]; s += v[i] * v[i]; }
        st8f(out + (size_t)row * 2048 + col, v); return s; }
    __device__ __forceinline__ void rowpart(const Unit& u, int rl, int wc, float part) const { atomicAdd(ssq + u.pm * 256 + rl, part); } };

#define XB_TMO      128
#define XB_XCNT(j)  (256  + 64 * (j))
#define XB_XSUB(j)  (1280 + 64 * (j))
#define XB_XGEN(j)  (2304 + 64 * (j))
#define XB_TOP      3328
#define XB_TOPGEN   3392
#define XCD_BAR_WORDS 3456
#define XB_SPIN_CAP (1u << 18)
__device__ __forceinline__ unsigned xb_ld(unsigned* p)              { return __hip_atomic_load(p, __ATOMIC_RELAXED, __HIP_MEMORY_SCOPE_AGENT); }
__device__ __forceinline__ unsigned xb_add(unsigned* p, unsigned v) { return __hip_atomic_fetch_add(p, v, __ATOMIC_RELAXED, __HIP_MEMORY_SCOPE_AGENT); }
__device__ __forceinline__ unsigned xb_xcc_id() { return (unsigned)__builtin_amdgcn_s_getreg((3 << 11) | 20) & 0xFu; }
#define XB_SPIN(cond, bar) do { unsigned _sp = 0; while (cond) { __builtin_amdgcn_s_sleep(1); \
    if ((++_sp & 255u) == 0u) { if (xb_ld(&(bar)[XB_TMO])) break; if (_sp > XB_SPIN_CAP) { atomicAdd(&(bar)[XB_TMO], 1u); break; } } } } while (0)
struct XcdBarrier { unsigned* bar; unsigned x; volatile LAS unsigned* st; };
__device__ __forceinline__ XcdBarrier xcd_barrier_post(unsigned* bar, volatile LAS unsigned* st) {
    XcdBarrier b; b.bar = bar; b.x = xb_xcc_id(); b.st = st;
    if (threadIdx.x == 0) (void)xb_add(&bar[XB_XCNT(b.x)], 1u);
    return b;
}
__device__ __forceinline__ void xcd_barrier_complete(unsigned* bar, unsigned x, unsigned& nloc, unsigned& nx) {
    const unsigned G = gridDim.x * gridDim.y * gridDim.z;
    unsigned sum, cnt, mine, sp = 0u;
    for (;;) {
        sum = 0u; cnt = 0u; mine = 0u;
#pragma unroll
        for (unsigned j = 0; j < 16; ++j) { const unsigned c = xb_ld(&bar[XB_XCNT(j)]); sum += c; cnt += (c > 0u) ? 1u : 0u; mine = (j == x) ? c : mine; }
        if (sum == G) break;
        __builtin_amdgcn_s_sleep(1);
        if ((++sp & 255u) == 0u) { if (xb_ld(&bar[XB_TMO])) break; if (sp > XB_SPIN_CAP) { atomicAdd(&bar[XB_TMO], 1u); break; } }
    }
    nloc = mine > 0u ? mine : 1u; nx = cnt > 0u ? cnt : 1u;
}
__device__ __forceinline__ void xcd_barrier(const XcdBarrier& b) {
    asm volatile("s_waitcnt vmcnt(0)" ::: "memory");
    __syncthreads();
    if (threadIdx.x == 0) {
        unsigned* bar = b.bar;
        __builtin_amdgcn_s_waitcnt(0);
        unsigned nloc = b.st[0], nx = b.st[1];
        if (nloc == 0u) { xcd_barrier_complete(bar, b.x, nloc, nx); b.st[0] = nloc; b.st[1] = nx; }
        const unsigned old = xb_add(&bar[XB_XSUB(b.x)], 1u);
        const unsigned gen = old / nloc;
        if (old + 1u == (gen + 1u) * nloc) {
            __builtin_amdgcn_fence(__ATOMIC_RELEASE, "agent");
            asm volatile("s_waitcnt vmcnt(0)" ::: "memory");
            const unsigned og = xb_add(&bar[XB_TOP], 1u);
            const unsigned tg = og / nx;
            if (og + 1u == (tg + 1u) * nx) xb_add(&bar[XB_TOPGEN], 1u);
            else XB_SPIN(xb_ld(&bar[XB_TOPGEN]) == tg, bar);
            __builtin_amdgcn_fence(__ATOMIC_ACQUIRE, "agent");
            xb_add(&bar[XB_XGEN(b.x)], 1u);
            asm volatile("s_waitcnt vmcnt(0)" ::: "memory");
        } else {
            XB_SPIN(xb_ld(&bar[XB_XGEN(b.x)]) == gen, bar);
            __builtin_amdgcn_fence(__ATOMIC_ACQUIRE, "agent");
            asm volatile("s_waitcnt vmcnt(0)" ::: "memory");
        }
    }
    __syncthreads();
}

constexpr int RING_BYTES = 131072;
constexpr int XCH_OFF = RING_BYTES;
constexpr int TAB_OFF = RING_BYTES + 4096;
constexpr int MISC_OFF = RING_BYTES + 8192;
constexpr int LDS_BYTES = 147456;

#define CAS __attribute__((address_space(4)))
struct Args { const float* in[31]; float* out; unsigned char* ws; int ph_lo, ph_hi; };
__device__ __forceinline__ const CAS Args* kargs() { const CAS Args* p = (const CAS Args*)__builtin_amdgcn_kernarg_segment_ptr(); asm volatile("" : "+s"(p)); return p; }
struct Ctx { const CAS Args* A; unsigned char* ws; int G, tid, lane, wid; LAS unsigned char* lds; };
__device__ __forceinline__ Ctx make_ctx(LAS unsigned char* lds) { Ctx C; C.A = kargs(); C.ws = C.A->ws; C.G = gridDim.x; int t = threadIdx.x; asm volatile("" : "+v"(t)); C.tid = t; C.lane = t & 63; C.wid = __builtin_amdgcn_readfirstlane(t >> 6); C.lds = lds; return C; }
#define WSP(T, off) ((T*)(C.ws + (off)))

__device__ __forceinline__ void tr_item(const float* W, int Kd, int Nd, bf16_t* T, const float* ksc, float mul, int blk, int tstride, int toff, LAS float* scr, int item, int lane) {
    const int nblk = Nd / 32, kb = item / nblk, nb = item % nblk, k0 = 64 * kb, n0 = 32 * nb;
    float wv[32];
#pragma unroll
    for (int i = 0; i < 32; ++i) wv[i] = W[(size_t)(k0 + 2 * i + (lane >> 5)) * Nd + n0 + (lane & 31)];
#pragma unroll
    for (int i = 0; i < 32; ++i) { const int kk = 2 * i + (lane >> 5); scr[kk * 33 + (lane & 31)] = wv[i] * (ksc ? ksc[k0 + kk] : 1.f) * mul; }
    asm volatile("s_waitcnt lgkmcnt(0)" ::: "memory");
    const int c = lane & 7;
#pragma unroll
    for (int j = 0; j < 4; ++j) { const int n = (lane >> 3) + 8 * j; const LAS float* sp = scr + (8 * c) * 33 + n; float v[8];
#pragma unroll
        for (int q = 0; q < 8; ++q) v[q] = sp[q * 33];
        const int nn = n0 + n, tr = (nn / blk) * tstride + toff + nn % blk; st8bf(T + (size_t)tr * Kd + k0 + 8 * c, v); }
    asm volatile("s_waitcnt lgkmcnt(0)" ::: "memory");
}
__device__ __forceinline__ void s5_apow(const float* are, const float* aim, const float* lstep, int g, int p, float n, float& re, float& im) {
    const float st = expf(lstep[g]) * n, mag = expf(are[g * 64 + p] * st), ang = aim[g * 64 + p] * st; float s, c; sincosf(ang, &s, &c); re = mag * c; im = mag * s; }
__device__ __forceinline__ void s5_kappa(const float* are, const float* aim, const float* lstep, int g, int p, float& kr, float& ki) {
    float ar, ai; s5_apow(are, aim, lstep, g, p, 1.f, ar, ai); const float x = ar - 1.f, y = ai, u = are[g * 64 + p], v = aim[g * 64 + p], d = 1.f / (u * u + v * v);
    kr = (x * u + y * v) * d; ki = (y * u - x * v) * d; }

__device__ __forceinline__ void phase_prologue(LAS unsigned char* lds_) {
    const Ctx C = make_ctx(lds_); const CAS Args* A = C.A; const int gt = blockIdx.x * NTHR + C.tid, gs = C.G * NTHR;
    { LAS float* scr = (LAS float*)(C.lds + C.wid * 8704); const int gw = blockIdx.x * NWAVES + C.wid, ngw = C.G * NWAVES;
      constexpr int I_IN = 32 * 208, I_H = 4 * 8, I_UPM = 16 * 64, I_UPS = 8 * 64, I_GLU = 8 * 16, I_OUT = 32 * 64, I_FF = 32 * 176, I_D = 88 * 64;
      constexpr int NIT = I_IN + 12 * I_H + I_UPM + I_UPS + I_GLU + I_OUT + 2 * I_FF + I_D;
      for (int it = gw; it < NIT; it += ngw) { int r = it;
          if (r < I_IN) { tr_item(A->in[2], 2048, INC, WSP(bf16_t, WS_WIN), A->in[1], 1.f, INC, 0, 0, scr, r, C.lane); continue; } r -= I_IN;
          if (r < 12 * I_H) { const int mat = r / (4 * I_H), h = (r / I_H) & 3, ri = r % I_H;
              const float* src = (mat == 0 ? A->in[5] : (mat == 1 ? A->in[6] : A->in[7])) + h * 65536; bf16_t* dst = (mat == 0 ? WSP(bf16_t, WS_WQ) : (mat == 1 ? WSP(bf16_t, WS_WK) : WSP(bf16_t, WS_WV))) + h * 65536;
              tr_item(src, 256, 256, dst, nullptr, mat == 1 ? 0.0625f : 1.f, 256, 0, 0, scr, ri, C.lane); continue; } r -= 12 * I_H;
          if (r < I_UPM) { tr_item(A->in[12], 1024, 2048, WSP(bf16_t, WS_WUPM), nullptr, 1.f, 2048, 0, 0, scr, r, C.lane); continue; } r -= I_UPM;
          if (r < I_UPS) { tr_item(A->in[23], 512, 2048, WSP(bf16_t, WS_WUPS), nullptr, 1.f, 2048, 0, 0, scr, r, C.lane); continue; } r -= I_UPS;
          if (r < I_GLU) { tr_item(A->in[21], 512, 512, WSP(bf16_t, WS_WGLU), nullptr, 1.f, 512, 0, 0, scr, r, C.lane); continue; } r -= I_GLU;
          if (r < I_OUT) { tr_item(A->in[25], 2048, 2048, WSP(bf16_t, WS_WOUT), nullptr, 1.f, 2048, 0, 0, scr, r, C.lane); continue; } r -= I_OUT;
          if (r < I_FF) { tr_item(A->in[27], 2048, FF, WSP(bf16_t, WS_WGU), A->in[26], 1.f, 128, 256, 0, scr, r, C.lane); continue; } r -= I_FF;
          if (r < I_FF) { tr_item(A->in[28], 2048, FF, WSP(bf16_t, WS_WGU), A->in[26], 1.f, 128, 256, 128, scr, r, C.lane); continue; } r -= I_FF;
          tr_item(A->in[29], FF, 2048, WSP(bf16_t, WS_WD), nullptr, 1.f, 2048, 0, 0, scr, r, C.lane); } }
    __syncthreads();
    { bf16_t* wg = WSP(bf16_t, WS_WG); const float* wq = A->in[5]; const float* wk = A->in[6]; const float* wv = A->in[7]; const float* wif = A->in[8];
      for (int k = blockIdx.x * NWAVES + C.wid; k < 2048; k += C.G * NWAVES) { float s[8];
#pragma unroll
          for (int o = 0; o < 8; ++o) s[o] = 0.f;
          const int kk = k & 1023, h = kk >> 8, d = kk & 255, e0 = C.lane * 4;
          if (k < 1024) { const f32x4 q4 = *(const f32x4*)(wq + (size_t)(h * 256 + d) * 256 + e0), k4 = *(const f32x4*)(wk + (size_t)(h * 256 + d) * 256 + e0);
#pragma unroll
              for (int j = 0; j < 4; ++j) { float a[8], b[8]; ld8f(wif + (size_t)(h * 256 + e0 + j) * 8, a); ld8f(wif + (size_t)(1024 + h * 256 + e0 + j) * 8, b);
#pragma unroll
                  for (int o = 0; o < 8; ++o) s[o] += q4[j] * a[o] + 0.0625f * k4[j] * b[o]; } }
          else { const f32x4 v4 = *(const f32x4*)(wv + (size_t)(h * 256 + d) * 256 + e0);
#pragma unroll
              for (int j = 0; j < 4; ++j) { float a[8]; ld8f(wif + (size_t)(2048 + h * 256 + e0 + j) * 8, a);
#pragma unroll
                  for (int o = 0; o < 8; ++o) s[o] += v4[j] * a[o]; } }
#pragma unroll
          for (int o = 0; o < 8; ++o) s[o] = wave_sum(s[o]);
          if (C.lane < 8) { float t = s[0];
#pragma unroll
              for (int o = 1; o < 8; ++o) t = (C.lane == o) ? s[o] : t;
              const float hi = bfround(t); wg[(size_t)C.lane * 2048 + k] = f2bf(hi); wg[(size_t)(C.lane + 8) * 2048 + k] = f2bf(t - hi); } } }
    if (C.G >= 32) { const int g = blockIdx.x & 31, sub = blockIdx.x >> 5, nsub = C.G >> 5;
      if (sub < nsub) {
      const float* are = A->in[13]; const float* aim = A->in[14]; const float* ls = A->in[15]; const float* bre = A->in[16] + (size_t)g * 1024; const float* bim = A->in[17] + (size_t)g * 1024;
      const float* cre = A->in[18] + (size_t)g * 1024; const float* cim = A->in[19] + (size_t)g * 1024;
      bf16_t* em = WSP(bf16_t, WS_EMAT) + (size_t)g * 65536; bf16_t* t16 = WSP(bf16_t, WS_T16O) + (size_t)g * 98304;
      LAS float* A1 = (LAS float*)(C.lds + 73728);
      LAS float* A2 = A1 + 64 * 17 * 2;
      for (int e = C.tid; e < 64 * 17; e += NTHR) { const int p = e / 17, n = e % 17; float pr, pi, kr, ki; s5_apow(are, aim, ls, g, p, (float)n, pr, pi); s5_kappa(are, aim, ls, g, p, kr, ki);
          A1[e * 2] = pr; A1[e * 2 + 1] = pi; A2[e * 2] = pr * kr - pi * ki; A2[e * 2 + 1] = pr * ki + pi * kr; }
      __syncthreads();
      for (int it = sub * NTHR + C.tid; it < 128 * 16; it += nsub * NTHR) { const int s = it & 15, rp = it >> 4, ri = rp >> 6, p = rp & 63;
          const float cr = A2[(p * 17 + 15 - s) * 2], ci = A2[(p * 17 + 15 - s) * 2 + 1]; float v[8];
#pragma unroll
          for (int hf = 0; hf < 2; ++hf) {
#pragma unroll
              for (int j = 0; j < 8; ++j) { const float br = bre[p * 16 + hf * 8 + j], bi = bim[p * 16 + hf * 8 + j]; v[j] = ri ? (cr * bi + ci * br) : (cr * br - ci * bi); }
              st8bf(em + (size_t)rp * 256 + s * 16 + hf * 8, v); } }
      for (int it = sub * NTHR + C.tid; it < 4096; it += nsub * NTHR) { u32x4 z = {0u, 0u, 0u, 0u}; *(u32x4*)(em + (size_t)128 * 256 + (size_t)it * 8) = z; }
      for (int it = sub * NTHR + C.tid; it < 16 * 256; it += nsub * NTHR) { const int cp = it & 15, c = (it >> 4) & 15, lag = it >> 8; float acc = 0.f;
          for (int p = 0; p < 64; ++p) { const float xr = A2[(p * 17 + lag) * 2], xi = A2[(p * 17 + lag) * 2 + 1], br = bre[p * 16 + cp], bi = bim[p * 16 + cp];
              const float yr = xr * br - xi * bi, yi = xr * bi + xi * br; acc += cre[c * 64 + p] * yr - cim[c * 64 + p] * yi; }
          const bf16_t w = f2bf(acc);
          for (int t = lag; t < 16; ++t) t16[(size_t)(t * 16 + c) * 384 + (t - lag) * 16 + cp] = w; }
      for (int it = sub * NTHR + C.tid; it < 256 * 16; it += nsub * NTHR) { const int s = it & 15, row = it >> 4, t = row >> 4;
          if (s > t) { u32x4 z = {0u, 0u, 0u, 0u}; bf16_t* d = t16 + (size_t)row * 384 + s * 16; *(u32x4*)d = z; *(u32x4*)(d + 8) = z; } }
      for (int it = sub * NTHR + C.tid; it < 256 * 64; it += nsub * NTHR) { const int p = it & 63, row = it >> 6, t = row >> 4, c = row & 15;
          const float pr = A1[(p * 17 + t + 1) * 2], pi = A1[(p * 17 + t + 1) * 2 + 1], cr = cre[c * 64 + p], ci = cim[c * 64 + p];
          bf16_t* d = t16 + (size_t)row * 384 + 256; d[p] = f2bf(cr * pr - ci * pi); d[64 + p] = f2bf(-(cr * pi + ci * pr)); } } }
    { const float* x = A->in[0]; bf16_t* xb = WSP(bf16_t, WS_XB); float* rs = WSP(float, WS_RSTD1);
      for (int row = blockIdx.x * NWAVES + C.wid; row < M; row += C.G * NWAVES) { const float* xr = x + (size_t)row * 2048; float s = 0.f;
#pragma unroll
          for (int j = 0; j < 4; ++j) { float v[8]; ld8f(xr + j * 512 + C.lane * 8, v);
#pragma unroll
              for (int i = 0; i < 8; ++i) s += v[i] * v[i];
              st8bf(xb + (size_t)row * 2048 + j * 512 + C.lane * 8, v); }
          s = wave_sum(s); if (C.lane == 0) rs[row] = rsqrtf(s * (1.f / 2048.f) + EPS); } }
    { float* z2 = WSP(float, WS_SSQ2); float* z3 = WSP(float, WS_SSQ3); for (int i = gt; i < M; i += gs) { z2[i] = 0.f; z3[i] = 0.f; } }
}

__device__ __forceinline__ void build_mtab(LAS unsigned char* lds_) {
    const Ctx C = make_ctx(lds_);
    const float* cs = WSP(float, WS_CS); LAS float* tab = (LAS float*)(C.lds + TAB_OFF);
    for (int bh = C.wid; bh < 16; bh += NWAVES) { float bl = 0.f, am = 0.f;
        if (C.lane < 32) { bl = cs[(bh * 32 + C.lane) * 2]; am = cs[(bh * 32 + C.lane) * 2 + 1]; }
        float m = 0.f;
        for (int c = 0; c < 32; ++c) { const float blc = __shfl(bl, c), amc = __shfl(am, c); if (C.lane == 0) { tab[bh * 32 + c] = m; tab[512 + bh * 32 + c] = amc; } m = blc + fmaxf(m, amc); } }
    __syncthreads();
}

__device__ __forceinline__ void phase_conv(LAS unsigned char* lds_) {
    const Ctx C = make_ctx(lds_);
    bf16_t* xcm = WSP(bf16_t, WS_XCM); const float* cw = C.A->in[3]; const float* cb = C.A->in[4]; float* graw = WSP(float, WS_GRAW); const bf16_t* wg = WSP(bf16_t, WS_WG);
    LAS unsigned char* wl = C.lds;
    for (int i = C.tid; i < 16 * 256; i += NTHR) { const int r = i >> 8, c16 = i & 255; *(LAS u32x4*)(wl + r * 4112 + c16 * 16) = *(const u32x4*)(wg + (size_t)r * 2048 + c16 * 8); }
    __syncthreads();
    const int lane = C.lane, r = lane & 15, kq = lane >> 4;
    for (int item = blockIdx.x * NWAVES + C.wid; item < M / 16; item += C.G * NWAVES) {
        const int tok = item * 16 + r, t = tok & (SEQ - 1);
        f32x4 acc = {0.f, 0.f, 0.f, 0.f};
        for (int s0 = 0; s0 < 32; s0 += 4) {
            u32x4 raw[4][4]; float wt[4][4][8], bias[4][8];
#pragma unroll
            for (int ss = 0; ss < 4; ++ss) { const int ch = (s0 + ss) * 32 + kq * 8;
#pragma unroll
                for (int j = 0; j < 4; ++j) raw[ss][j] = (t - 3 + j >= 0) ? *(const u32x4*)(xcm + (size_t)(tok - 3 + j) * 2048 + 1024 + ch) : (u32x4){0u, 0u, 0u, 0u}; }
#pragma unroll
            for (int ss = 0; ss < 4; ++ss) { const int ch = (s0 + ss) * 32 + kq * 8; ld8f(cb + ch, bias[ss]);
#pragma unroll
                for (int j = 0; j < 4; ++j) ld8f(cw + j * 1024 + ch, wt[ss][j]); }
#pragma unroll
            for (int ss = 0; ss < 4; ++ss) { const int ch = (s0 + ss) * 32 + kq * 8; float y[8];
#pragma unroll
                for (int i = 0; i < 8; ++i) y[i] = bias[ss][i];
#pragma unroll
                for (int j = 0; j < 4; ++j) { float xv[8]; unpack8(raw[ss][j], xv);
#pragma unroll
                    for (int i = 0; i < 8; ++i) y[i] += xv[i] * wt[ss][j][i]; }
#pragma unroll
                for (int i = 0; i < 8; ++i) y[i] = y[i] * sigmoidf_(y[i]);
                u32x4 xcp; xcp.x = cvt_pk_bf16(y[0], y[1]); xcp.y = cvt_pk_bf16(y[2], y[3]); xcp.z = cvt_pk_bf16(y[4], y[5]); xcp.w = cvt_pk_bf16(y[6], y[7]);
                *(u32x4*)(xcm + (size_t)tok * 2048 + ch) = xcp;
                const bf16x8 bc = *(const LAS bf16x8*)(wl + r * 4112 + ch * 2), bm = *(const LAS bf16x8*)(wl + r * 4112 + (1024 + ch) * 2);
                acc = __builtin_amdgcn_mfma_f32_16x16x32_bf16(__builtin_bit_cast(bf16x8, xcp), bc, acc, 0, 0, 0);
                acc = __builtin_amdgcn_mfma_f32_16x16x32_bf16(__builtin_bit_cast(bf16x8, raw[ss][3]), bm, acc, 0, 0, 0); } }
#pragma unroll
        for (int i = 0; i < 4; ++i) { float v = acc[i]; v += __shfl_xor(v, 8); graw[(size_t)(item * 16 + 4 * kq + i) * 16 + r] = (r < 8) ? v : 0.f; }
    }
}

__device__ __forceinline__ void phase_scans(LAS unsigned char* lds_) {
    const Ctx C = make_ctx(lds_);
    const float* graw = WSP(float, WS_GRAW); const float* bif = C.A->in[9];
    float* ta = WSP(float, WS_TA); float* tb = WSP(float, WS_TB); float* tpm = WSP(float, WS_TPM); float* cs = WSP(float, WS_CS);
    const int gw = blockIdx.x * NWAVES + C.wid, lane = C.lane;
    if (gw < 512) { const int z = gw, c = z & 31, bh = z >> 5, h = bh & 3, b = bh >> 2, row0 = b * SEQ + c * LC + lane * 4;
        const float bi = bif[h], bfg = bif[4 + h]; float li[4], bb[4], aa[4], pm[4]; float run = 0.f;
#pragma unroll
        for (int i = 0; i < 4; ++i) { const float* g = graw + (size_t)(row0 + i) * 16; li[i] = g[h] + g[8 + h] + bi; const float gf = g[4 + h] + g[12 + h] + bfg;
            const float lf = fminf(gf, 0.f) - log1pf(expf(-fabsf(gf))); run += lf; bb[i] = run; }
        float incl = run;
#pragma unroll
        for (int o = 1; o < 64; o <<= 1) { const float t = __shfl_up(incl, o); if (lane >= o) incl += t; }
        const float excl = incl - run; float mx = -INFINITY;
#pragma unroll
        for (int i = 0; i < 4; ++i) { bb[i] += excl; aa[i] = li[i] - bb[i]; mx = fmaxf(mx, aa[i]); pm[i] = mx; }
        float imx = mx;
#pragma unroll
        for (int o = 1; o < 64; o <<= 1) { const float t = __shfl_up(imx, o); if (lane >= o) imx = fmaxf(imx, t); }
        float emx = __shfl_up(imx, 1); if (lane == 0) emx = -INFINITY;
#pragma unroll
        for (int i = 0; i < 4; ++i) pm[i] = fmaxf(pm[i], emx);
        const size_t o4 = (size_t)h * M + row0;
        *(f32x4*)(ta + o4) = (f32x4){aa[0], aa[1], aa[2], aa[3]}; *(f32x4*)(tb + o4) = (f32x4){bb[0], bb[1], bb[2], bb[3]}; *(f32x4*)(tpm + o4) = (f32x4){pm[0], pm[1], pm[2], pm[3]};
        if (lane == 63) { cs[z * 2] = bb[3]; cs[z * 2 + 1] = pm[3]; }
    } else {
        const int ts = (gw - 512) * 64 + lane;
        if (ts < BATCH * NG * SP) { const int p = ts & 63, g = (ts >> 6) & 31, b = ts >> 11; const float* e = WSP(float, WS_E); bf16_t* up = WSP(bf16_t, WS_UP);
            float ar, ai; s5_apow(C.A->in[13], C.A->in[14], C.A->in[15], g, p, 16.f, ar, ai); float sr = 0.f, si = 0.f;
            for (int j0 = 0; j0 < 512; j0 += 8) { float er[8], ei[8];
#pragma unroll
                for (int j = 0; j < 8; ++j) { const size_t o = ((size_t)(b * 512 + j0 + j) * 32 + g) * 128; er[j] = e[o + p]; ei[j] = e[o + 64 + p]; }
#pragma unroll
                for (int j = 0; j < 8; ++j) { bf16_t* d = up + ((size_t)(b * 512 + j0 + j) * 32 + g) * 384 + 256; d[p] = f2bf(sr); d[64 + p] = f2bf(si);
                    const float nr = ar * sr - ai * si + er[j], ni = ar * si + ai * sr + ei[j]; sr = nr; si = ni; } } }
    }
}

__device__ __forceinline__ void phase_state(LAS unsigned char* lds_) {
    const Ctx C = make_ctx(lds_);
    const float* cs = WSP(float, WS_CS); const bf16_t* dcl = WSP(bf16_t, WS_DCL); bf16_t* vc = WSP(bf16_t, WS_VC);
    LAS float* tab = (LAS float*)(C.lds + TAB_OFF);
    LAS float* nst = (LAS float*)(C.lds);
    const int w = blockIdx.x, bh = w >> 4, sl = w & 15, h = bh & 3, b = bh >> 2, tid = C.tid;
    if (w >= 256) return;
    if (tid < 64) { float bl = 0.f, am = 0.f; if (tid < 32) { bl = cs[(bh * 32 + tid) * 2]; am = cs[(bh * 32 + tid) * 2 + 1]; }
        float m = 0.f;
        for (int c = 0; c < 32; ++c) { const float blc = __shfl(bl, c), amc = __shfl(am, c), mx = fmaxf(m, amc);
            if (tid == 0) { tab[c * 4] = __expf(m - mx); tab[c * 4 + 1] = __expf(amc - mx); tab[c * 4 + 2] = m; }
            m = blc + mx; } }
    __syncthreads();
    if (tid < 256) { const float* nlp = WSP(float, WS_NLP); float n = 0.f;
        for (int c = 0; c < 2 * sl + 1; ++c) { if (c == 2 * sl) nst[tid] = n;
            const f32x4 pv = *(const f32x4*)(nlp + ((size_t)(bh * 32 + c) * 256 + tid) * 4); n = tab[c * 4] * n + tab[c * 4 + 1] * ((pv[0] + pv[1]) + (pv[2] + pv[3])); }
        if (sl == 0) nst[tid] = 0.f;
        nst[256 + tid] = n; }
    { const int off = sl * 4096 + tid * 8, e = off >> 8, j = off & 255; float cst[8];
#pragma unroll
      for (int i = 0; i < 8; ++i) cst[i] = 0.f;
      for (int c = 0; c < 32; ++c) { const size_t z = (size_t)bh * 32 + c; float d[8]; ld8bf(dcl + z * 65536 + off, d);
          st8bf(vc + (z * 256 + e) * 512 + 256 + j, cst);
          const float dc = tab[c * 4], sc = tab[c * 4 + 1];
#pragma unroll
          for (int i = 0; i < 8; ++i) cst[i] = dc * cst[i] + sc * d[i]; } }
    __syncthreads();
    { const int cl = tid >> 8, c = 2 * sl + cl, row = b * SEQ + c * LC + (tid & 255); const bf16_t* q = WSP(bf16_t, WS_Q) + (size_t)row * 1024 + h * 256; float qn = 0.f;
      for (int k = 0; k < 256; k += 8) { float qv[8]; ld8bf(q + k, qv);
#pragma unroll
          for (int i = 0; i < 8; ++i) qn += qv[i] * nst[cl * 256 + k + i]; }
      const float mc = tab[c * 4 + 2], Mt = fmaxf(mc, WSP(float, WS_TPM)[(size_t)h * M + row]), bt = WSP(float, WS_TB)[(size_t)h * M + row];
      const f32x4 dp = *(const f32x4*)(WSP(float, WS_DENP) + ((size_t)h * M + row) * 4);
      const float den = (dp[0] + dp[1]) + (dp[2] + dp[3]) + __expf(mc - Mt) * qn;
      WSP(float, WS_RDN)[(size_t)h * M + row] = 1.f / fmaxf(fabsf(den), __expf(-(bt + Mt))); }
}

__device__ __forceinline__ void phase_final(LAS unsigned char* lds_) {
    const Ctx C = make_ctx(lds_);
    float* out = C.A->out; const float* ssq = WSP(float, WS_SSQ3); const float* g = C.A->in[30];
    for (int row = blockIdx.x * NWAVES + C.wid; row < M; row += C.G * NWAVES) { const float r = rsqrtf(ssq[row] * (1.f / 2048.f) + EPS); float* o = out + (size_t)row * 2048;
#pragma unroll
        for (int j = 0; j < 4; ++j) { float v[8], gg[8]; ld8f(o + j * 512 + C.lane * 8, v); ld8f(g + j * 512 + C.lane * 8, gg);
#pragma unroll
            for (int i = 0; i < 8; ++i) v[i] = v[i] * r * gg[i];
            st8f(o + j * 512 + C.lane * 8, v); } }
}

#ifndef MK_N_LAUNCHES
#define MK_N_LAUNCHES 1
#endif
#ifndef NAIVE_MASK
#define NAIVE_MASK 0u
#endif
constexpr int NPH = 14;
constexpr int CW_BAR = 1024;
#ifndef EPI2_MASK
#define EPI2_MASK 0u
#endif
#ifndef JOB_MASK
#define JOB_MASK 0xffffffffu
#endif
#define GEMM(id, MODE, lda, ldb, K, S, f) do { if constexpr (!(((JOB_MASK) >> (id)) & 1u)) {} else if constexpr (((NAIVE_MASK) >> (id)) & 1u) gemm_naive<MODE>(lds, lda, ldb, K, S, f); else gemm_phase<MODE, decltype(f), decltype(S), (((EPI2_MASK) >> (id)) & 1u) != 0u>(lds, lda, ldb, K, S, f); } while (0)

__global__ void __launch_bounds__(NTHR, 2) fwd_kernel(Args args) {
    extern __shared__ __attribute__((aligned(16))) unsigned char lds_raw[];
    LAS unsigned char* lds = (LAS unsigned char*)lds_raw;
    volatile LAS unsigned* MISC = (volatile LAS unsigned*)(lds + MISC_OFF);
    if (threadIdx.x < 32) MISC[threadIdx.x] = 0u;
    __syncthreads();
    XcdBarrier bar; bar.bar = (unsigned*)(args.ws + WS_CTL) + CW_BAR; bar.x = 0; bar.st = nullptr;
    if (MK_N_LAUNCHES == 1) bar = xcd_barrier_post((unsigned*)(args.ws + WS_CTL) + CW_BAR, MISC + 8);
    const int lo = args.ph_lo, hi = args.ph_hi;
#ifndef PH_MASK
#define PH_MASK 0xffffu
#endif
#define IN(k) ((((PH_MASK) >> (k)) & 1u) && lo <= (k) && (k) < hi)
#define SEAM(k) do { if (MK_N_LAUNCHES == 1) { if (IN(k) && IN((k) + 1)) xcd_barrier(bar); } } while (0)
#define W(T, off) ((T*)(ws + (off)))
#ifndef REP_MASK
#define REP_MASK 0u
#endif
#define PH_RUN(k, ...) if (IN(k)) { { __VA_ARGS__ } if constexpr (((REP_MASK) >> (k)) & 1u) { xcd_barrier(bar); { __VA_ARGS__ } } }
#define PHASE_ARGS const CAS Args* A = kargs(); unsigned char* ws = A->ws; const int G = gridDim.x, bx = blockIdx.x; (void)ws; (void)G; (void)bx

    PH_RUN(0, phase_prologue(lds); )
    SEAM(0);
    PH_RUN(1, PHASE_ARGS; RegSched S; S.init(W(char, WS_XB), 4096, W(char, WS_WIN), 4096, 128, 26, G, bx);
        FG1 f{W(float, WS_RSTD1), W(bf16_t, WS_XCM), W(bf16_t, WS_SIGO), W(bf16_t, WS_UP), (bf16_t*)A->out, A->in[24]};
        GEMM(0, 0, 4096, 4096, 2048, S, f); )
    SEAM(1);
    PH_RUN(2, PHASE_ARGS; phase_conv(lds); __syncthreads();
        { MapSched<MapX> S{{W(char, WS_UP), W(char, WS_EMAT)}, 256, G, bx}; FX f{W(float, WS_E)}; GEMM(2, 0, 24576, 512, 256, S, f); })
    SEAM(2);
    PH_RUN(4, phase_scans(lds); )
    SEAM(4);
    PH_RUN(5, PHASE_ARGS; build_mtab(lds); const LAS float* mtab = (const LAS float*)(lds + TAB_OFF);
        { MapSched<MapProjN> S{{W(char, WS_XCM), W(char, WS_WQ), 0}, 512, G, bx}; FQ f{W(bf16_t, WS_Q), W(bf16_t, WS_SQ), W(float, WS_TPM), mtab, 0.f}; GEMM(3, 0, 4096, 512, 256, S, f); }
        { MapSched<MapProjN> S{{W(char, WS_XCM), W(char, WS_WK), 0}, 512, G, bx}; FK f{W(bf16_t, WS_K)}; GEMM(4, 0, 4096, 512, 256, S, f); }
        { MapSched<MapProjT> S{{W(char, WS_XCM), W(char, WS_WK), 0}, 512, G, bx}; FKT f{W(bf16_t, WS_KT), W(float, WS_NLP), W(float, WS_TA), mtab, 0.f}; GEMM(5, 1, 512, 4096, 256, S, f); }
        { MapSched<MapProjT> S{{W(char, WS_XCM), W(char, WS_WV), 2048}, 512, G, bx}; FVT f{W(bf16_t, WS_VC), W(bf16_t, WS_VWT), W(float, WS_TA), mtab, 0.f}; GEMM(6, 0, 512, 4096, 256, S, f); } )
    SEAM(5);
    PH_RUN(6, PHASE_ARGS; build_mtab(lds); const LAS float* mtab = (const LAS float*)(lds + TAB_OFF);
        { MapSched<MapU1> S{{W(char, WS_Q), W(char, WS_K)}, 512, G, bx}; FU1 f{W(bf16_t, WS_SQ), W(float, WS_DENP), W(float, WS_TA), W(float, WS_TPM), mtab, 0.f}; GEMM(7, 1, 2048, 2048, 256, S, f); }
        { MapSched<MapU2> S{{W(char, WS_VWT), W(char, WS_KT)}, 512, G, bx}; FU2 f{W(bf16_t, WS_DCL)}; GEMM(8, 0, KTLD * 2, KTLD * 2, 256, S, f); }
        { MapSched<MapY> S{{W(char, WS_UP), W(char, WS_T16O)}, 256, G, bx}; FY f{W(bf16_t, WS_UP), W(bf16_t, WS_YSP), A->in[20]}; GEMM(9, 0, 24576, 768, 384, S, f); } )
    SEAM(6);
    PH_RUN(7, PHASE_ARGS; phase_state(lds); __syncthreads();
        { RegSched S; S.init(W(char, WS_YSP), 1024, W(char, WS_WGLU), 1024, 128, 2, G, bx); FG5 f{W(bf16_t, WS_YSP), W(bf16_t, WS_YS), A->in[22]}; GEMM(10, 0, 1024, 1024, 512, S, f); } )
    SEAM(7);
    PH_RUN(8, PHASE_ARGS;
        { MapSched<MapU4> S{{W(char, WS_SQ), W(char, WS_VC)}, 512, G, bx}; FU4 f{W(float, WS_RDN), W(bf16_t, WS_SIGO), W(bf16_t, WS_XCM), A->in[10], A->in[11], W(bf16_t, WS_OUTM)}; GEMM(11, 2, 4096, 1024, 512, S, f); }
        { RegSched S; S.init(W(char, WS_YS), 1024, W(char, WS_WUPS), 1024, 128, 8, G, bx); FG6 f{(const bf16_t*)A->out, W(bf16_t, WS_TMP)}; GEMM(12, 0, 1024, 1024, 512, S, f); } )
    SEAM(8);
    PH_RUN(9, PHASE_ARGS; RegSched S; S.init(W(char, WS_OUTM), 2048, W(char, WS_WUPM), 2048, 128, 8, G, bx); FG4 f{(const bf16_t*)A->out, W(bf16_t, WS_TMP), W(bf16_t, WS_MERGED)}; GEMM(13, 0, 2048, 2048, 1024, S, f); )
    SEAM(9);
    PH_RUN(10, PHASE_ARGS; RegSched S; S.init(W(char, WS_MERGED), 4096, W(char, WS_WOUT), 4096, 128, 8, G, bx); FG7 f{A->in[0], W(bf16_t, WS_X1B), W(float, WS_SSQ2)}; GEMM(14, 1, 4096, 4096, 2048, S, f); )
    SEAM(10);
    PH_RUN(11, PHASE_ARGS; RegSched S; S.init(W(char, WS_X1B), 4096, W(char, WS_WGU), 4096, 128, 44, G, bx); FG8 f{W(float, WS_SSQ2), W(bf16_t, WS_HB)}; GEMM(15, 3, 4096, 4096, 2048, S, f); )
    SEAM(11);
    PH_RUN(12, PHASE_ARGS; RegSched S; S.init(W(char, WS_HB), 11264, W(char, WS_WD), 11264, 128, 8, G, bx); FG9 f{W(bf16_t, WS_X1B), A->out, W(float, WS_SSQ3)}; GEMM(16, 1, 11264, 11264, 5632, S, f); )
    SEAM(12);
    PH_RUN(13, phase_final(lds); )
#undef IN
#undef SEAM
#undef W
}

extern "C" void kernel_launch(void* const* d_in, const int* in_sizes, int n_in, void* d_out, int out_size, void* d_ws, size_t ws_size, hipStream_t stream) {
    static int grid = 0;
    if (grid == 0) {
        if (n_in != 31 || in_sizes[0] != M * DM || out_size != M * DM || ws_size < WS_END) { fprintf(stderr, "kernel_launch: unexpected shapes (n_in %d, in0 %d, out %d, ws %zu); nothing launched\n", n_in, n_in > 0 ? in_sizes[0] : -1, out_size, ws_size); grid = -1; return; }
        int dev = 0, cus = 0, per_cu = 0;
        if (hipGetDevice(&dev) != hipSuccess || hipDeviceGetAttribute(&cus, hipDeviceAttributeMultiprocessorCount, dev) != hipSuccess) { grid = -1; return; }
        if (hipFuncSetAttribute((const void*)fwd_kernel, hipFuncAttributeMaxDynamicSharedMemorySize, LDS_BYTES) != hipSuccess) { fprintf(stderr, "kernel_launch: hipFuncSetAttribute failed\n"); grid = -1; return; }
        if (hipOccupancyMaxActiveBlocksPerMultiprocessor(&per_cu, (const void*)fwd_kernel, NTHR, LDS_BYTES) != hipSuccess || per_cu < 1) fprintf(stderr, "kernel_launch: occupancy query reports %d\n", per_cu);
        (void)hipGetLastError();
        grid = cus;
    }
    if (grid < 0) return;
    if (hipMemsetAsync((char*)d_ws + WS_CTL, 0, CTL_ZERO_BYTES, stream) != hipSuccess) return;
    Args a{};
    for (int i = 0; i < 31; ++i) a.in[i] = (const float*)d_in[i];
    a.out = (float*)d_out; a.ws = (unsigned char*)d_ws;
    if (MK_N_LAUNCHES == 1) { a.ph_lo = 0; a.ph_hi = NPH; hipLaunchKernelGGL(fwd_kernel, dim3(grid), dim3(NTHR), LDS_BYTES, stream, a); }
    else for (int p = 0; p < NPH; ++p) { a.ph_lo = p; a.ph_hi = p + 1; hipLaunchKernelGGL(fwd_kernel, dim3(grid), dim3(NTHR), LDS_BYTES, stream, a); }
}
```
